# Optimizing an MI355X kernel written in HIP

```python
import math
import jax
import jax.numpy as jnp
from jax import lax
import numpy as np

D_MODEL = 1024
BATCH = 32
SEQ = 2048
DEPTH = 2

HEAD_DIM = 64
SSD_WIDTH = 3 * D_MODEL // 8
LRU_WIDTH = D_MODEL // 4
FOX_WIDTH = D_MODEL - SSD_WIDTH - LRU_WIDTH
SSD_HEADS = SSD_WIDTH // HEAD_DIM
SSD_GROUPS = 2
SSD_STATE = 128
SSD_CONV = 4
SSD_CONV_DIM = SSD_WIDTH + 2 * SSD_GROUPS * SSD_STATE
SSD_CHUNK = 128
LRU_BLOCKS = 4
LRU_BLOCK = LRU_WIDTH // LRU_BLOCKS
LRU_CONV = 4
LRU_C = 8.0
FOX_HEADS = FOX_WIDTH // HEAD_DIM
Q_BLOCK = 128
D_FF = ((8 * D_MODEL + 3 * 256 - 1) // (3 * 256)) * 256
PLE_DIM = 256
IN_SPLITS = (SSD_WIDTH, SSD_CONV_DIM, SSD_HEADS, LRU_WIDTH, LRU_WIDTH,
             FOX_WIDTH, FOX_WIDTH, FOX_WIDTH, FOX_HEADS)
IN_COLS = sum(IN_SPLITS)
EPS = 1e-6

kernel_name = "hymba_style_ssd_rglru_fox_trunk"


def _rmsnorm(x, g):
    xf = x.astype(jnp.float32)
    y = xf * lax.rsqrt(jnp.mean(xf * xf, axis=-1, keepdims=True) + EPS)
    return (y * g.astype(jnp.float32)).astype(x.dtype)


def _causal_dwconv(x, w, b):
    k, c = w.shape
    y = lax.conv_general_dilated(
        x, w[:, None, :].astype(x.dtype), window_strides=(1,),
        padding=[(k - 1, 0)], dimension_numbers=("NWC", "WIO", "NWC"),
        feature_group_count=c)
    return y + b.astype(x.dtype)


def _ssd(xs, dt, a, bm, cm, d_skip):
    b, s, h, p = xs.shape
    g, n = bm.shape[2], bm.shape[3]
    nc = s // SSD_CHUNK
    rep = h // g
    bh = jnp.repeat(bm, rep, axis=2)
    chh = jnp.repeat(cm, rep, axis=2)
    xdt = xs * dt[..., None]
    adt = a * dt
    chunk = lambda t: t.reshape((b, nc, SSD_CHUNK) + t.shape[2:])
    xc, bc, cc, ac = chunk(xdt), chunk(bh), chunk(chh), chunk(adt)
    acs = jnp.cumsum(ac, axis=2)
    seg = acs[:, :, :, None, :] - acs[:, :, None, :, :]
    causal = jnp.tril(jnp.ones((SSD_CHUNK, SSD_CHUNK), bool))
    lmat = jnp.exp(jnp.where(causal[None, None, :, :, None], seg, -jnp.inf))
    scores = jnp.einsum("bclhn,bcshn->bclsh", cc, bc) * lmat
    y_diag = jnp.einsum("bclsh,bcshp->bclhp", scores, xc)
    decay_s = jnp.exp(acs[:, :, -1:, :] - acs)
    states = jnp.einsum("bclhn,bclh,bclhp->bchpn", bc, decay_s, xc)
    chunk_decay = jnp.exp(acs[:, :, -1, :])

    def step(carry, inp):
        st, dec = inp
        return carry * dec[..., None, None] + st, carry

    init = jnp.zeros((b, h, p, n), states.dtype)
    _, prev = lax.scan(step, init, (jnp.moveaxis(states, 1, 0),
                                    jnp.moveaxis(chunk_decay, 1, 0).astype(states.dtype)))
    prev = jnp.moveaxis(prev, 0, 1)
    y_off = jnp.einsum("bclhn,bchpn,bclh->bclhp", cc, prev, jnp.exp(acs))
    y = (y_diag + y_off).reshape(b, s, h, p) + xs * d_skip[:, None]
    return y.astype(xs.dtype)


def _rglru(x, w_a, b_a, w_x, b_x, lam):
    b, s, w = x.shape
    xb = x.reshape(b, s, LRU_BLOCKS, LRU_BLOCK)
    r = jax.nn.sigmoid(jnp.einsum("bsgi,gij->bsgj", xb, w_a).reshape(b, s, w) + b_a)
    i = jax.nn.sigmoid(jnp.einsum("bsgi,gij->bsgj", xb, w_x).reshape(b, s, w) + b_x)
    log_a = -LRU_C * r.astype(jnp.float32) * jax.nn.softplus(-lam.astype(jnp.float32))
    a = jnp.exp(log_a)
    mult = jnp.sqrt(-jnp.expm1(2.0 * log_a))
    u = mult * (i * x).astype(jnp.float32)

    def comb(lhs, rhs):
        a1, b1 = lhs
        a2, b2 = rhs
        return a1 * a2, a2 * b1 + b2

    _, hseq = lax.associative_scan(comb, (a, u), axis=1)
    return hseq.astype(x.dtype)


def _forgetting_attention(q, k, v, log_f):
    s, e = q.shape[1], q.shape[3]
    cum = jnp.cumsum(log_f, axis=-1)
    scale = e ** -0.5
    outs = []
    for blk in range(s // Q_BLOCK):
        q0, q1 = blk * Q_BLOCK, (blk + 1) * Q_BLOCK
        logits = jnp.einsum("bqhe,bkhe->bhqk", q[:, q0:q1], k[:, :q1]).astype(jnp.float32) * scale
        logits = logits + cum[:, :, q0:q1, None] - cum[:, :, None, :q1]
        mask = (q0 + jnp.arange(Q_BLOCK))[:, None] >= jnp.arange(q1)[None, :]
        logits = jnp.where(mask[None, None], logits, -jnp.inf)
        probs = jax.nn.softmax(logits, axis=-1).astype(v.dtype)
        outs.append(jnp.einsum("bhqk,bkhe->bqhe", probs, v[:, :q1]))
    return jnp.concatenate(outs, axis=1)


def _mixer(u, w_in, ssd_conv_w, ssd_conv_b, ssd_dt_bias, ssd_a_log, ssd_d, ssd_norm_g,
           lru_conv_w, lru_conv_b, lru_w_a, lru_b_a, lru_w_x, lru_b_x, lru_lambda, lru_norm_g,
           fox_b_f, fox_norm_g, w_out):
    b, s, _ = u.shape
    proj = u @ w_in
    offs = [int(o) for o in np.cumsum(IN_SPLITS)[:-1]]
    (z, xbc, dt_raw, lru_x, lru_gate, fq, fk, fv, f_raw) = jnp.split(proj, offs, axis=-1)

    xbc = jax.nn.silu(_causal_dwconv(xbc, ssd_conv_w, ssd_conv_b))
    xs, bm, cm = jnp.split(xbc, [SSD_WIDTH, SSD_WIDTH + SSD_GROUPS * SSD_STATE], axis=-1)
    xs = xs.reshape(b, s, SSD_HEADS, HEAD_DIM)
    bm = bm.reshape(b, s, SSD_GROUPS, SSD_STATE)
    cm = cm.reshape(b, s, SSD_GROUPS, SSD_STATE)
    dt = jax.nn.softplus(dt_raw.astype(jnp.float32) + ssd_dt_bias.astype(jnp.float32))
    a = -jnp.exp(ssd_a_log.astype(jnp.float32))
    y_ssd = _ssd(xs, dt, a, bm, cm, ssd_d).reshape(b, s, SSD_WIDTH)
    y_ssd = _rmsnorm(y_ssd * jax.nn.silu(z), ssd_norm_g)

    xl = _causal_dwconv(lru_x, lru_conv_w, lru_conv_b)
    hl = _rglru(xl, lru_w_a, lru_b_a, lru_w_x, lru_b_x, lru_lambda)
    y_lru = _rmsnorm(hl * jax.nn.gelu(lru_gate), lru_norm_g)

    q = fq.reshape(b, s, FOX_HEADS, HEAD_DIM)
    k = fk.reshape(b, s, FOX_HEADS, HEAD_DIM)
    v = fv.reshape(b, s, FOX_HEADS, HEAD_DIM)
    log_f = jnp.transpose(jax.nn.log_sigmoid(f_raw.astype(jnp.float32) + fox_b_f.astype(jnp.float32)), (0, 2, 1))
    y_fox = _forgetting_attention(q, k, v, log_f).reshape(b, s, FOX_WIDTH)
    y_fox = _rmsnorm(y_fox, fox_norm_g)

    return jnp.concatenate([y_ssd, y_lru, y_fox], axis=-1) @ w_out


def setup_inputs(seed: int = 0) -> dict:
    key = jax.random.key(seed)
    ks = jax.random.split(key, 32)
    f32 = jnp.float32
    L = DEPTH
    nrm = lambda k, shape, scale: jax.random.normal(k, shape, f32) * scale
    gain = lambda k, shape: 1.0 + 0.02 * jax.random.normal(k, shape, f32)
    dt0 = jnp.exp(jax.random.uniform(ks[6], (L, SSD_HEADS), f32, math.log(1e-3), math.log(1e-1)))
    lam_s = jax.random.uniform(ks[16], (L, LRU_WIDTH), f32, 0.9, 0.999) ** (1.0 / LRU_C)
    return {
        "x": jax.random.normal(ks[0], (BATCH, SEQ, D_MODEL), f32),
        "p": jax.random.normal(ks[1], (L, BATCH, SEQ, PLE_DIM), f32),
        "norm1_g": gain(ks[2], (L, D_MODEL)),
        "w_in": nrm(ks[3], (L, D_MODEL, IN_COLS), D_MODEL ** -0.5),
        "ssd_conv_w": nrm(ks[4], (L, SSD_CONV, SSD_CONV_DIM), SSD_CONV ** -0.5),
        "ssd_conv_b": nrm(ks[5], (L, SSD_CONV_DIM), 0.02),
        "ssd_dt_bias": dt0 + jnp.log(-jnp.expm1(-dt0)),
        "ssd_a_log": jnp.log(jax.random.uniform(ks[7], (L, SSD_HEADS), f32, 1.0, 16.0)),
        "ssd_d": gain(ks[8], (L, SSD_HEADS)),
        "ssd_norm_g": gain(ks[9], (L, SSD_WIDTH)),
        "lru_conv_w": nrm(ks[10], (L, LRU_CONV, LRU_WIDTH), LRU_CONV ** -0.5),
        "lru_conv_b": nrm(ks[11], (L, LRU_WIDTH), 0.02),
        "lru_w_a": nrm(ks[12], (L, LRU_BLOCKS, LRU_BLOCK, LRU_BLOCK), LRU_BLOCK ** -0.5),
        "lru_b_a": nrm(ks[13], (L, LRU_WIDTH), 0.02),
        "lru_w_x": nrm(ks[14], (L, LRU_BLOCKS, LRU_BLOCK, LRU_BLOCK), LRU_BLOCK ** -0.5),
        "lru_b_x": nrm(ks[15], (L, LRU_WIDTH), 0.02),
        "lru_lambda": jnp.log(lam_s) - jnp.log1p(-lam_s),
        "lru_norm_g": gain(ks[17], (L, LRU_WIDTH)),
        "fox_b_f": 3.0 + nrm(ks[18], (L, FOX_HEADS), 0.1),
        "fox_norm_g": gain(ks[19], (L, FOX_WIDTH)),
        "w_out": nrm(ks[20], (L, D_MODEL, D_MODEL), D_MODEL ** -0.5),
        "norm2_g": gain(ks[21], (L, D_MODEL)),
        "w_gate": nrm(ks[22], (L, D_MODEL, D_FF), D_MODEL ** -0.5),
        "w_up": nrm(ks[23], (L, D_MODEL, D_FF), D_MODEL ** -0.5),
        "w_down": nrm(ks[24], (L, D_FF, D_MODEL), D_FF ** -0.5),
        "norm3_g": gain(ks[25], (L, D_MODEL)),
        "w_ple_gate": nrm(ks[26], (L, D_MODEL, D_MODEL), D_MODEL ** -0.5),
        "b_ple_gate": nrm(ks[27], (L, D_MODEL), 0.02),
        "w_ple_proj": nrm(ks[28], (L, PLE_DIM, D_MODEL), PLE_DIM ** -0.5),
        "final_norm_g": gain(ks[29], (D_MODEL,)),
    }


def reference(x, p, norm1_g, w_in, ssd_conv_w, ssd_conv_b, ssd_dt_bias, ssd_a_log, ssd_d,
              ssd_norm_g, lru_conv_w, lru_conv_b, lru_w_a, lru_b_a, lru_w_x, lru_b_x,
              lru_lambda, lru_norm_g, fox_b_f, fox_norm_g, w_out, norm2_g, w_gate, w_up,
              w_down, norm3_g, w_ple_gate, b_ple_gate, w_ple_proj, final_norm_g):
    h = x
    for i in range(DEPTH):
        u = _rmsnorm(h, norm1_g[i])
        h = h + _mixer(u, w_in[i], ssd_conv_w[i], ssd_conv_b[i], ssd_dt_bias[i], ssd_a_log[i],
                       ssd_d[i], ssd_norm_g[i], lru_conv_w[i], lru_conv_b[i], lru_w_a[i],
                       lru_b_a[i], lru_w_x[i], lru_b_x[i], lru_lambda[i], lru_norm_g[i],
                       fox_b_f[i], fox_norm_g[i], w_out[i])
        u = _rmsnorm(h, norm2_g[i])
        h = h + (jax.nn.silu(u @ w_gate[i]) * (u @ w_up[i])) @ w_down[i]
        u = _rmsnorm(h, norm3_g[i])
        gate = jax.nn.sigmoid(u @ w_ple_gate[i] + b_ple_gate[i])
        h = h + gate * (p[i] @ w_ple_proj[i])
    return _rmsnorm(h, final_norm_g)
```

```cpp
#include <hip/hip_runtime.h>
#include <cstdio>
#include <cstdint>
namespace pg8 {
#define PG8_LAS __attribute__((address_space(3)))
typedef unsigned short bf16_t;
typedef short bf16x8 __attribute__((ext_vector_type(8)));
typedef float f32x4 __attribute__((ext_vector_type(4)));
typedef unsigned u32x4 __attribute__((ext_vector_type(4)));
constexpr int BM = 256, BK = 64, HALF = 128, HTB = HALF * BK * 2  , STAGE_BYTES = 8 * HTB, NXCD = 8, WGM = 8;

__host__ __device__ __forceinline__ int lds_byte(int r, int c) { const int st = (r >> 4) * 2 + (c >> 5), rr = r & 15, cc = c & 31, ob = rr * 64 + cc * 2; return st * 1024 + (ob ^ (((ob >> 9) & 1) << 5)); }
__host__ __device__ __forceinline__ void stage_rc(int b, int& R, int& C) { const int st = b / 1024, sb = b % 1024, swz = sb ^ (((sb >> 9) & 1) << 5); R = (st >> 1) * 16 + swz / 64; C = (st & 1) * 32 + (swz % 64) / 2; }
__host__ __device__ __forceinline__ int perm32(int rho) { const int n = rho >> 4, i = rho & 15; return 8 * (i >> 2) + 4 * n + (i & 3); }

struct Unit { int pm, pn; };
struct Gemm { const bf16_t* A; const bf16_t* Bt; int M, N, K; };

struct StaticOrder {
    int nM, nN, nwg, G, c;
    __host__ __device__ void init(int M, int N, int G_, int c_) { nM = M / BM; nN = N / BM; nwg = nM * nN; G = G_; c = c_; }
    __host__ __device__ bool next(int i, Unit& u) const {
        const long L = (long)i * G + c; if (L >= nwg) return false;
        int wgid = (int)L; { const int q = nwg / NXCD, r = nwg % NXCD, xcd = wgid % NXCD, off = wgid / NXCD; wgid = (xcd < r ? xcd * (q + 1) : r * (q + 1) + (xcd - r) * q) + off; }
        const int nig = WGM * nN, gid = wgid / nig, fm = gid * WGM, gsz = (nM - fm) < WGM ? (nM - fm) : WGM;
        u.pm = fm + ((wgid % nig) % gsz); u.pn = (wgid % nig) / gsz; return true;
    }
    __device__ __forceinline__ void a_ready(const Unit&) const {}
    __device__ __forceinline__ void done(const Unit&) const {}
};

__device__ __forceinline__ unsigned cvt_pk_bf16(float lo, float hi) { unsigned r; asm volatile("v_cvt_pk_bf16_f32 %0, %1, %2" : "=v"(r) : "v"(lo), "v"(hi)); return r; }
typedef float f32x2 __attribute__((ext_vector_type(2)));
__device__ __forceinline__ f32x2 gelu_pk(f32x2 v) {
    const f32x2 av = __builtin_elementwise_abs(v), d = av * 0.2316418882f + 1.0f;
    f32x2 t; t.x = __builtin_amdgcn_rcpf(d.x); t.y = __builtin_amdgcn_rcpf(d.y);
    f32x2 q = t * 0.5307027145f + (-0.7265760135f); q = q * t + 0.7107068705f; q = q * t + (-0.142248368f); q = q * t + 0.127414796f; q = q * t;
    const f32x2 s = (v * v) * (-0.72134752044f);
    f32x2 e; e.x = __builtin_amdgcn_exp2f(s.x); e.y = __builtin_amdgcn_exp2f(s.y);
    const f32x2 m = v * (q * e), r = v - m;
    f32x2 o; o.x = v.x < 0.f ? m.x : r.x; o.y = v.y < 0.f ? m.y : r.y; return o;
}

template <int ACT  > struct EpiBf16 {
    static constexpr bool PERM = true, AFTER_DRAIN = false; static_assert(ACT == 0 || ACT == 1, "EpiBf16: ACT is 0 (none) or 1 (gelu_pk)");
    bf16_t* O; int ldc; const float* bias; int split_cols; size_t split_stride; float scale0;
    __device__ __forceinline__ void operator()(const f32x4 (&acc)[2][2][4][2], const Unit& u, int wr, int wc, int fr, int fq) const {
        const int row0 = u.pm * BM + wr * 64 + fr; int colt = u.pn * BM; bf16_t* base = O;
        float sc = 1.f; if (split_cols) { const int t = colt / split_cols; base += (size_t)t * split_stride; colt -= t * split_cols; if (t == 0) sc = scale0; }
        const int col0 = colt + wc * 32 + 8 * fq, bcol0 = u.pn * BM + wc * 32 + 8 * fq;
        f32x4 bv[2][2];
#pragma unroll
        for (int bj = 0; bj < 2; ++bj)
#pragma unroll
            for (int n = 0; n < 2; ++n) bv[bj][n] = bias ? *(const f32x4*)(bias + bcol0 + bj * HALF + 4 * n) : (f32x4){0.f, 0.f, 0.f, 0.f};
#pragma unroll
        for (int ai = 0; ai < 2; ++ai)
#pragma unroll
            for (int m = 0; m < 4; ++m) { bf16_t* rowp = base + (size_t)(row0 + ai * HALF + m * 16) * ldc + col0;
#pragma unroll
                for (int bj = 0; bj < 2; ++bj) { f32x4 v0 = acc[ai][bj][m][0] + bv[bj][0], v1 = acc[ai][bj][m][1] + bv[bj][1];
                    if (ACT == 1) { f32x2 a = gelu_pk((f32x2){v0[0], v0[1]}), b = gelu_pk((f32x2){v0[2], v0[3]}), c = gelu_pk((f32x2){v1[0], v1[1]}), d = gelu_pk((f32x2){v1[2], v1[3]});
                        v0 = (f32x4){a.x, a.y, b.x, b.y}; v1 = (f32x4){c.x, c.y, d.x, d.y}; }
                    v0 = v0 * sc; v1 = v1 * sc; u32x4 w; w.x = cvt_pk_bf16(v0[0], v0[1]); w.y = cvt_pk_bf16(v0[2], v0[3]); w.z = cvt_pk_bf16(v1[0], v1[1]); w.w = cvt_pk_bf16(v1[2], v1[3]);
                    *(u32x4*)(rowp + bj * HALF) = w; } }
    }
};
template <class Epi, class Sched, bool ALIGN_EPI = false, bool SP2 = false>
__device__ __forceinline__ void gemm_phase(PG8_LAS unsigned char* lds, const Gemm g, const Sched& S, const Epi& E) {
    int tid_ = threadIdx.x; asm volatile("" : "+v"(tid_));
    const int tid = tid_, wid = __builtin_amdgcn_readfirstlane(tid >> 6), lane = tid & 63, wr = wid >> 2, wc = wid & 3, fr = lane & 15, fq = lane >> 4;
    const int K = g.K, nt = K / BK;
    unsigned voffA[2], voffB[2];
#pragma unroll
    for (int i = 0; i < 2; ++i) { int R, C; stage_rc(tid * 16 + i * 8192, R, C); const int Rb = Epi::PERM ? ((R & ~31) + perm32(R & 31)) : R;
        voffA[i] = (unsigned)(R * K + C) * 2u; voffB[i] = (unsigned)(Rb * K + C) * 2u; }
    const size_t kstep = (size_t)(BK * 2);
    const size_t hstep = (size_t)HALF * K * 2;
    const size_t tstep = 2 * hstep;
    const unsigned ldsw = (unsigned)wid * 1024u;
    const int aoff = lds_byte(wr * 64 + fr, fq * 8), boff = lds_byte(wc * 32 + fr, fq * 8);
#define PG8_SA(b, h) (((b) * 2 + (h)) * HTB)
#define PG8_SB(b, h) ((4 + (b) * 2 + (h)) * HTB)
#define PG8_STAGE(bufoff, gbase, voff) do { _Pragma("unroll") for (int _i = 0; _i < 2; ++_i) \
        __builtin_amdgcn_global_load_lds((const unsigned*)((const char*)(gbase) + (voff)[_i]), (PG8_LAS unsigned*)(lds + (bufoff) + ldsw + _i * 8192), 16, 0, 0); } while (0)
#define PG8_LDA(dst, b, h) do { _Pragma("unroll") for (int m = 0; m < 4; ++m) _Pragma("unroll") for (int k = 0; k < 2; ++k) dst[m][k] = *(const PG8_LAS bf16x8*)(lds + PG8_SA(b, h) + aoff + m * 2048 + k * 1024); } while (0)
#define PG8_LDB(dst, b, h) do { _Pragma("unroll") for (int n = 0; n < 2; ++n) _Pragma("unroll") for (int k = 0; k < 2; ++k) dst[n][k] = *(const PG8_LAS bf16x8*)(lds + PG8_SB(b, h) + boff + n * 2048 + k * 1024); } while (0)
#define PG8_MMA(ai, bj, At, Bt) do { __builtin_amdgcn_s_setprio(1); _Pragma("unroll") for (int m = 0; m < 4; ++m) _Pragma("unroll") for (int n = 0; n < 2; ++n) _Pragma("unroll") for (int k = 0; k < 2; ++k) \
        acc[ai][bj][m][n] = __builtin_amdgcn_mfma_f32_16x16x32_bf16(Bt[n][k], At[m][k], acc[ai][bj][m][n], 0, 0, 0); __builtin_amdgcn_s_setprio(0); } while (0)
#define PG8_WAIT_V(n) asm volatile("s_waitcnt vmcnt(" #n ")" ::: "memory")
#define PG8_WAIT_L(n) asm volatile("s_waitcnt lgkmcnt(" #n ")" ::: "memory")
#define PG8_BAR __builtin_amdgcn_s_barrier()
#define PG8_SCHED __builtin_amdgcn_sched_barrier(0)
    Unit cur, nxt; int ui = 0;
    if (!S.next(0, cur)) return;
    f32x4 acc[2][2][4][2];
#pragma unroll
    for (int a = 0; a < 2; ++a)
#pragma unroll
        for (int b = 0; b < 2; ++b)
#pragma unroll
            for (int m = 0; m < 4; ++m)
#pragma unroll
                for (int n = 0; n < 2; ++n) acc[a][b][m][n] = (f32x4){0.f, 0.f, 0.f, 0.f};
    bf16x8 At[4][2], B0[2][2], B1[2][2];
    const char* cA = (const char*)g.A + (size_t)cur.pm * tstep; const char* cB = (const char*)g.Bt + (size_t)cur.pn * tstep;
    S.a_ready(cur);
    if constexpr (SP2) {
        PG8_STAGE(PG8_SB(0, 0), cB, voffB); PG8_STAGE(PG8_SB(0, 1), cB + hstep, voffB); PG8_STAGE(PG8_SA(0, 0), cA, voffA); PG8_STAGE(PG8_SA(0, 1), cA + hstep, voffA);
        if (wr == 1) PG8_BAR;
        PG8_WAIT_V(2); PG8_BAR;
        PG8_STAGE(PG8_SB(1, 0), cB + kstep, voffB); PG8_STAGE(PG8_SA(1, 0), cA + kstep, voffA); PG8_STAGE(PG8_SB(1, 1), cB + hstep + kstep, voffB);
        PG8_WAIT_V(6); PG8_BAR;
    } else {
        PG8_STAGE(PG8_SB(0, 0), cB, voffB); PG8_STAGE(PG8_SA(0, 0), cA, voffA); PG8_STAGE(PG8_SB(0, 1), cB + hstep, voffB); PG8_STAGE(PG8_SA(0, 1), cA + hstep, voffA);
        if (wr == 1) PG8_BAR;
        PG8_WAIT_V(4); PG8_BAR;
        PG8_STAGE(PG8_SB(1, 0), cB + kstep, voffB); PG8_STAGE(PG8_SA(1, 0), cA + kstep, voffA); PG8_STAGE(PG8_SB(1, 1), cB + hstep + kstep, voffB);
        PG8_WAIT_V(6); PG8_BAR;
    }
    for (;;) {
        const bool has_next = S.next(ui + 1, nxt);
        const char* nA = has_next ? (const char*)g.A + (size_t)nxt.pm * tstep : cA; const char* nB = has_next ? (const char*)g.Bt + (size_t)nxt.pn * tstep : cB;
        for (int t = 0; t < nt; t += 2) {
            const bool last = (t == nt - 2);
            const char* a1 = cA + (size_t)(t + 1) * kstep;
            const char* a2 = last ? nA : cA + (size_t)(t + 2) * kstep; const char* b2 = last ? nB : cB + (size_t)(t + 2) * kstep;
            const char* a3 = a2 + kstep; const char* b3 = b2 + kstep;
            if (last && has_next) S.a_ready(nxt);
            if constexpr (SP2) {
            PG8_LDB(B0, 0, 0); PG8_LDB(B1, 0, 1); PG8_SCHED; PG8_LDA(At, 0, 0); PG8_STAGE(PG8_SA(1, 1), a1 + hstep, voffA);
            PG8_WAIT_V(8); PG8_WAIT_L(0); PG8_BAR; PG8_MMA(0, 0, At, B0); PG8_MMA(0, 1, At, B1); PG8_BAR; PG8_SCHED;
            PG8_LDA(At, 0, 1); PG8_STAGE(PG8_SB(0, 0), b2, voffB); PG8_STAGE(PG8_SB(0, 1), b2 + hstep, voffB); PG8_STAGE(PG8_SA(0, 0), a2, voffA);
            PG8_WAIT_V(8); PG8_WAIT_L(0); PG8_BAR; PG8_MMA(1, 0, At, B0); PG8_MMA(1, 1, At, B1); PG8_BAR; PG8_SCHED;
            PG8_LDB(B0, 1, 0); PG8_LDB(B1, 1, 1); PG8_SCHED; PG8_LDA(At, 1, 0); PG8_STAGE(PG8_SA(0, 1), a2 + hstep, voffA);
            PG8_WAIT_V(8); PG8_WAIT_L(0); PG8_BAR; PG8_MMA(0, 0, At, B0); PG8_MMA(0, 1, At, B1); PG8_BAR; PG8_SCHED;
            PG8_LDA(At, 1, 1); PG8_STAGE(PG8_SB(1, 0), b3, voffB); PG8_STAGE(PG8_SB(1, 1), b3 + hstep, voffB); PG8_STAGE(PG8_SA(1, 0), a3, voffA);
            PG8_WAIT_V(8); PG8_WAIT_L(0); PG8_BAR; PG8_MMA(1, 0, At, B0); PG8_MMA(1, 1, At, B1); PG8_BAR; PG8_SCHED;
            } else {
            PG8_LDB(B0, 0, 0); PG8_SCHED; PG8_LDA(At, 0, 0); PG8_STAGE(PG8_SA(1, 1), a1 + hstep, voffA);
            PG8_WAIT_L(8); PG8_BAR; PG8_WAIT_L(0); PG8_MMA(0, 0, At, B0); PG8_BAR; PG8_SCHED;
            PG8_LDB(B1, 0, 1); PG8_STAGE(PG8_SB(0, 0), b2, voffB);
            PG8_BAR; PG8_WAIT_L(0); PG8_MMA(0, 1, At, B1); PG8_BAR;
            PG8_LDA(At, 0, 1); PG8_STAGE(PG8_SA(0, 0), a2, voffA);
            PG8_BAR; PG8_WAIT_L(0); PG8_MMA(1, 0, At, B0); PG8_BAR; PG8_SCHED;
            PG8_STAGE(PG8_SB(0, 1), b2 + hstep, voffB);
            PG8_WAIT_V(6); PG8_BAR; PG8_MMA(1, 1, At, B1); PG8_BAR;
            PG8_LDB(B0, 1, 0); PG8_SCHED; PG8_LDA(At, 1, 0); PG8_STAGE(PG8_SA(0, 1), a2 + hstep, voffA);
            PG8_WAIT_L(8); PG8_BAR; PG8_WAIT_L(0); PG8_MMA(0, 0, At, B0); PG8_BAR; PG8_SCHED;
            PG8_LDB(B1, 1, 1); PG8_STAGE(PG8_SB(1, 0), b3, voffB);
            PG8_BAR; PG8_WAIT_L(0); PG8_MMA(0, 1, At, B1); PG8_BAR;
            PG8_LDA(At, 1, 1); PG8_STAGE(PG8_SA(1, 0), a3, voffA);
            PG8_BAR; PG8_WAIT_L(0); PG8_MMA(1, 0, At, B0); PG8_BAR; PG8_SCHED;
            PG8_STAGE(PG8_SB(1, 1), b3 + hstep, voffB);
            PG8_WAIT_V(6); PG8_BAR; PG8_MMA(1, 1, At, B1); PG8_BAR;
            }
        }
        if constexpr (ALIGN_EPI) { if (wr == 0) PG8_BAR; }
        if constexpr (!Epi::AFTER_DRAIN) { E(acc, cur, wr, wc, fr, fq); S.done(cur); }
        if (!has_next) break;
#pragma unroll
        for (int a = 0; a < 2; ++a)
#pragma unroll
            for (int b = 0; b < 2; ++b)
#pragma unroll
                for (int m = 0; m < 4; ++m)
#pragma unroll
                    for (int n = 0; n < 2; ++n) acc[a][b][m][n] = (f32x4){0.f, 0.f, 0.f, 0.f};
        cur = nxt; cA = nA; cB = nB; ++ui;
        if constexpr (ALIGN_EPI) { if (wr == 1) PG8_BAR; }
    }
    PG8_WAIT_V(0);
    if constexpr (!ALIGN_EPI) { if (wr == 0) PG8_BAR; }
    PG8_BAR;
    if constexpr (Epi::AFTER_DRAIN) { E.fused(acc, cur, wr, wc, fr, fq, lds, wid, lane); S.done(cur); }
#undef PG8_SA
#undef PG8_SB
#undef PG8_STAGE
#undef PG8_LDA
#undef PG8_LDB
#undef PG8_MMA
#undef PG8_WAIT_V
#undef PG8_WAIT_L
#undef PG8_BAR
#undef PG8_SCHED
}
}

#include <hip/hip_cooperative_groups.h>
namespace cg = cooperative_groups;

#define DEV __device__ __forceinline__
#define LAS __attribute__((address_space(3)))
typedef LAS unsigned char* lptr;
typedef unsigned short bf16_t;
typedef short bf16x8 __attribute__((ext_vector_type(8)));
typedef float f32x4 __attribute__((ext_vector_type(4)));
typedef unsigned u32x4 __attribute__((ext_vector_type(4)));
typedef unsigned u32x2 __attribute__((ext_vector_type(2)));
typedef short v4i16_t __attribute__((ext_vector_type(4)));

constexpr int NB = 32, SEQ = 2048, DM = 1024, MTOK = NB * SEQ;
constexpr int NPROJ = 3072, DFF = 2816, PLE = 256;
constexpr int NLAYER = 2;
constexpr float EPSN = 1e-6f;
constexpr int C_Z = 0, C_X = 384, C_B = 768, C_C = 1024, C_LX = 1280, C_LG = 1536, C_Q = 1792, C_K = 2176, C_V = 2560, C_DT = 2944;

constexpr size_t MiB = 1u << 20;
constexpr size_t WS_CTL = 0;
constexpr size_t WS_RS = 1 * MiB;
constexpr size_t WS_SIDE = 5 * MiB;
constexpr size_t WS_WIN = 9 * MiB;
constexpr size_t WS_WOUT = 21 * MiB;
constexpr size_t WS_WGU = 25 * MiB;
constexpr size_t WS_WDN = 47 * MiB;
constexpr size_t WS_WPG = 58 * MiB;
constexpr size_t WS_WPP = 62 * MiB;
constexpr size_t WS_HBA = 64 * MiB;
constexpr size_t WS_Y = 192 * MiB;
constexpr size_t WS_PP = 320 * MiB;
constexpr size_t WS_PB = 448 * MiB;
constexpr size_t WS_PROJ = 512 * MiB;
constexpr size_t WS_END = 896 * MiB;
enum { RS_IN0 = 0, RS_IN1 = 1, RS_FINAL = 2, RS_N2 = 3  , RS_N3 = 5, RS_SSD = 7, RS_LRU = 9, RS_FOX = 11, RS_COUNT = 13 };

constexpr int LDS_BYTES = 147456;

struct Args { const float* in[30]; float* out; unsigned char* ws; int ph_lo, ph_hi; };

DEV unsigned f2bf(float f) { unsigned u = __builtin_bit_cast(unsigned, f); return (u + 0x7fffu + ((u >> 16) & 1u)) >> 16; }
DEV unsigned pk2(float lo, float hi) { return f2bf(lo) | (f2bf(hi) << 16); }
DEV float bf2f(unsigned v) { return __builtin_bit_cast(float, v << 16); }
DEV float bflo(unsigned w) { return __builtin_bit_cast(float, w << 16); }
DEV float bfhi(unsigned w) { return __builtin_bit_cast(float, w & 0xffff0000u); }
DEV float sigmoidf_(float x) { return 1.f / (1.f + __expf(-x)); }
DEV float siluf_(float x) { return x / (1.f + __expf(-x)); }
DEV float softplusf_(float x) { return fmaxf(x, 0.f) + log1pf(__expf(-fabsf(x))); }
DEV float gelu_tanhf_(float x) { const float u = 0.7978845608028654f * (x + 0.044715f * x * x * x); const float t = 1.f - 2.f / (1.f + __expf(2.f * u)); return 0.5f * x * (1.f + t); }
DEV void unpack8(const u32x4 r, float (&v)[8]) { v[0] = bflo(r.x); v[1] = bfhi(r.x); v[2] = bflo(r.y); v[3] = bfhi(r.y); v[4] = bflo(r.z); v[5] = bfhi(r.z); v[6] = bflo(r.w); v[7] = bfhi(r.w); }
DEV bf16x8 ldsA(lptr p) { return *(const LAS bf16x8*)p; }
DEV float wave_sum64(float v) {
#pragma unroll
    for (int o = 1; o < 64; o <<= 1) v += __shfl_xor(v, o);
    return v;
}
#define MFMA16(a, b, c) __builtin_amdgcn_mfma_f32_16x16x32_bf16((a), (b), (c), 0, 0, 0)
#define WGBAR() __syncthreads()

using pg8::Unit; using pg8::BM; using pg8::HALF; using pg8::cvt_pk_bf16;

struct EpiProj {
    static constexpr bool PERM = true, AFTER_DRAIN = false;
    bf16_t* O; const float* rowss; float* side;
    __device__ __forceinline__ void operator()(const f32x4 (&acc)[2][2][4][2], const Unit& u, int wr, int wc, int fr, int fq) const {
        const int row0 = u.pm * BM + wr * 64 + fr, col0 = u.pn * BM + wc * 32 + 8 * fq;
        const bool sidew = (u.pn == 11) && (wc == 0) && (fq < 2);
#pragma unroll
        for (int ai = 0; ai < 2; ++ai)
#pragma unroll
            for (int m = 0; m < 4; ++m) {
                const int row = row0 + ai * HALF + m * 16; const float rs = rsqrtf(rowss[row] * (1.f / 1024.f) + EPSN);
                bf16_t* rowp = O + (size_t)row * NPROJ + col0;
#pragma unroll
                for (int bj = 0; bj < 2; ++bj) { const f32x4 v0 = acc[ai][bj][m][0] * rs, v1 = acc[ai][bj][m][1] * rs;
                    u32x4 w; w.x = cvt_pk_bf16(v0[0], v0[1]); w.y = cvt_pk_bf16(v0[2], v0[3]); w.z = cvt_pk_bf16(v1[0], v1[1]); w.w = cvt_pk_bf16(v1[2], v1[3]);
                    *(u32x4*)(rowp + bj * HALF) = w;
                    if (bj == 1 && sidew) { *(f32x4*)(side + (size_t)row * 16 + 8 * fq) = v0; if (fq == 0) *(f32x4*)(side + (size_t)row * 16 + 4) = v1; } }
            }
    }
};
struct EpiResid {
    static constexpr bool PERM = false, AFTER_DRAIN = false;
    const float* hin; float* hout; bf16_t* hb; float* rowss_out;
    __device__ __forceinline__ void operator()(const f32x4 (&acc)[2][2][4][2], const Unit& u, int wr, int wc, int fr, int fq) const {
        const int row0 = u.pm * BM + wr * 64 + fr, col0 = u.pn * BM + wc * 32 + 4 * fq;
#pragma unroll
        for (int ai = 0; ai < 2; ++ai)
#pragma unroll
            for (int m = 0; m < 4; ++m) {
                const int row = row0 + ai * HALF + m * 16; float ss = 0.f;
#pragma unroll
                for (int bj = 0; bj < 2; ++bj)
#pragma unroll
                    for (int n = 0; n < 2; ++n) { const size_t off = (size_t)row * DM + col0 + bj * HALF + n * 16;
                        const f32x4 hv = *(const f32x4*)(hin + off) + acc[ai][bj][m][n];
                        *(f32x4*)(hout + off) = hv; u32x2 w; w.x = cvt_pk_bf16(hv[0], hv[1]); w.y = cvt_pk_bf16(hv[2], hv[3]); *(u32x2*)(hb + off) = w;
                        ss += (hv[0] * hv[0] + hv[1] * hv[1]) + (hv[2] * hv[2] + hv[3] * hv[3]); }
                ss += __shfl_xor(ss, 16); ss += __shfl_xor(ss, 32);
                if (fq == 0) unsafeAtomicAdd(rowss_out + row, ss);
            }
    }
};
struct EpiSwiGLU {
    static constexpr bool PERM = true, AFTER_DRAIN = false;
    bf16_t* O; const float* rowss;
    __device__ __forceinline__ void operator()(const f32x4 (&acc)[2][2][4][2], const Unit& u, int wr, int wc, int fr, int fq) const {
        const int row0 = u.pm * BM + wr * 64 + fr, col0 = u.pn * HALF + wc * 32 + 8 * fq;
#pragma unroll
        for (int ai = 0; ai < 2; ++ai)
#pragma unroll
            for (int m = 0; m < 4; ++m) {
                const int row = row0 + ai * HALF + m * 16; const float rs = rsqrtf(rowss[row] * (1.f / 1024.f) + EPSN);
                float o[8];
#pragma unroll
                for (int n = 0; n < 2; ++n)
#pragma unroll
                    for (int j = 0; j < 4; ++j) { const float g = acc[ai][0][m][n][j] * rs, uu = acc[ai][1][m][n][j] * rs; o[4 * n + j] = siluf_(g) * uu; }
                u32x4 w; w.x = cvt_pk_bf16(o[0], o[1]); w.y = cvt_pk_bf16(o[2], o[3]); w.z = cvt_pk_bf16(o[4], o[5]); w.w = cvt_pk_bf16(o[6], o[7]);
                *(u32x4*)(O + (size_t)row * DFF + col0) = w;
            }
    }
};
struct EpiPP {
    static constexpr bool PERM = true, AFTER_DRAIN = false;
    bf16_t* O;
    __device__ __forceinline__ void operator()(const f32x4 (&acc)[2][2][4][2], const Unit& u, int wr, int wc, int fr, int fq) const {
        const int row0 = u.pm * BM + wr * 64 + fr, col0 = u.pn * BM + wc * 32 + 8 * fq;
#pragma unroll
        for (int ai = 0; ai < 2; ++ai)
#pragma unroll
            for (int m = 0; m < 4; ++m) { bf16_t* rowp = O + (size_t)(row0 + ai * HALF + m * 16) * DM + col0;
#pragma unroll
                for (int bj = 0; bj < 2; ++bj) { const f32x4 v0 = acc[ai][bj][m][0], v1 = acc[ai][bj][m][1];
                    u32x4 w; w.x = cvt_pk_bf16(v0[0], v0[1]); w.y = cvt_pk_bf16(v0[2], v0[3]); w.z = cvt_pk_bf16(v1[0], v1[1]); w.w = cvt_pk_bf16(v1[2], v1[3]);
                    *(u32x4*)(rowp + bj * HALF) = w; } }
    }
};
struct EpiPle {
    static constexpr bool PERM = false, AFTER_DRAIN = false;
    float* h; bf16_t* hb; const bf16_t* pp; const float* bias; const float* rowss; float* rowss_out;
    __device__ __forceinline__ void operator()(const f32x4 (&acc)[2][2][4][2], const Unit& u, int wr, int wc, int fr, int fq) const {
        const int row0 = u.pm * BM + wr * 64 + fr, col0 = u.pn * BM + wc * 32 + 4 * fq;
#pragma unroll
        for (int ai = 0; ai < 2; ++ai)
#pragma unroll
            for (int m = 0; m < 4; ++m) {
                const int row = row0 + ai * HALF + m * 16; const float rs = rsqrtf(rowss[row] * (1.f / 1024.f) + EPSN); float ss = 0.f;
#pragma unroll
                for (int bj = 0; bj < 2; ++bj)
#pragma unroll
                    for (int n = 0; n < 2; ++n) { const int col = col0 + bj * HALF + n * 16; const size_t off = (size_t)row * DM + col;
                        const f32x4 bv = *(const f32x4*)(bias + col); const u32x2 pw = *(const u32x2*)(pp + off);
                        const f32x4 a = acc[ai][bj][m][n] * rs + bv; f32x4 hv = *(const f32x4*)(h + off);
                        hv[0] += sigmoidf_(a[0]) * bflo(pw.x); hv[1] += sigmoidf_(a[1]) * bfhi(pw.x); hv[2] += sigmoidf_(a[2]) * bflo(pw.y); hv[3] += sigmoidf_(a[3]) * bfhi(pw.y);
                        *(f32x4*)(h + off) = hv; u32x2 w; w.x = cvt_pk_bf16(hv[0], hv[1]); w.y = cvt_pk_bf16(hv[2], hv[3]); *(u32x2*)(hb + off) = w;
                        ss += (hv[0] * hv[0] + hv[1] * hv[1]) + (hv[2] * hv[2] + hv[3] * hv[3]); }
                ss += __shfl_xor(ss, 16); ss += __shfl_xor(ss, 32);
                if (fq == 0) unsafeAtomicAdd(rowss_out + row, ss);
            }
    }
};

struct InTab {
    DEV const float* operator[](int i) const { const __attribute__((address_space(4))) char* kp = (const __attribute__((address_space(4))) char*)__builtin_amdgcn_kernarg_segment_ptr();
        return *(const float* const __attribute__((address_space(4)))*)(kp + 8 * i); }
};
struct Ctx {
    InTab in; float* out; unsigned char* ws;
    lptr L; int tid, lane, wave, G, bid;
    DEV float* rs(int i) const { return (float*)(ws + WS_RS) + (size_t)i * MTOK; }
    DEV bf16_t* bfp(size_t off) const { return (bf16_t*)(ws + off); }
};

DEV void p0_item(const Ctx& c, const float* W0, const float* W1, int K, int N, int mode, const float* gain, const float* g1, const float* g2, bf16_t* dst, int item, int nblk) {
    LAS float* scr = (LAS float*)(c.L + c.wave * 16384);
    const int lane = c.lane, kb = item / nblk, nb = item % nblk, k0 = 64 * kb, n0 = 32 * nb;
    const int r = n0 + (lane & 31); int sc = r; const float* W = W0;
    if (mode == 1) { if (r < 1280) sc = r; else if (r < 2944) sc = r + 6; else if (r < 2950) sc = 1280 + (r - 2944); else if (r < 2956) sc = r; else sc = -1; }
    else if (mode == 2) { const int t = r >> 8, w = r & 255; sc = 128 * t + (w & 127); W = (w < 128) ? W0 : W1; }
#pragma unroll 8
    for (int i = 0; i < 32; ++i) { const int kk = 2 * i + (lane >> 5), k = k0 + kk; float gk = 1.f;
        if (gain) { if (g1) gk = (k < 384) ? gain[k] : (k < 640 ? g1[k - 384] : g2[k - 640]); else gk = gain[k]; }
        scr[kk * 33 + (lane & 31)] = (sc >= 0) ? W[(size_t)k * N + sc] * gk : 0.f; }
    asm volatile("s_waitcnt lgkmcnt(0)" ::: "memory");
    const int cc = lane & 7;
#pragma unroll
    for (int j = 0; j < 4; ++j) { const int n = (lane >> 3) + 8 * j; const LAS float* s = scr + (8 * cc) * 33 + n;
        u32x4 o; o.x = pk2(s[0 * 33], s[1 * 33]); o.y = pk2(s[2 * 33], s[3 * 33]); o.z = pk2(s[4 * 33], s[5 * 33]); o.w = pk2(s[6 * 33], s[7 * 33]);
        *(u32x4*)(dst + (size_t)(n0 + n) * K + k0 + 8 * cc) = o; }
    asm volatile("s_waitcnt lgkmcnt(0)" ::: "memory");
}
DEV void p0_prologue(const Ctx& c) {
    const int gw = c.bid * 8 + c.wave, NGW = c.G * 8;
    const int gt = c.bid * 512 + c.tid, NGT = c.G * 512;
    { f32x4* z = (f32x4*)c.rs(1); const int n4 = (RS_COUNT - 1) * MTOK / 4; for (int i = gt; i < n4; i += NGT) z[i] = (f32x4){0.f, 0.f, 0.f, 0.f};
      unsigned* ctl = (unsigned*)(c.ws + WS_CTL); for (int i = gt; i < 4096; i += NGT) ctl[i] = 0u; }
    constexpr int I_IN = 16 * 96, I_OUT = 16 * 32, I_GU = 16 * 176, I_DN = 44 * 32, I_PG = 16 * 32, I_PP = 4 * 32, I_L = I_IN + I_OUT + I_GU + I_DN + I_PG + I_PP;
    for (int it = gw; it < NLAYER * I_L; it += NGW) {
        const int l = it / I_L; int r = it % I_L;
        if (r < I_IN) { p0_item(c, c.in[3] + (size_t)l * 1024 * 2956, nullptr, 1024, 2956, 1, c.in[2] + l * 1024, nullptr, nullptr, c.bfp(WS_WIN) + (size_t)l * NPROJ * 1024, r, 96); continue; } r -= I_IN;
        if (r < I_OUT) { p0_item(c, c.in[20] + (size_t)l * 1024 * 1024, nullptr, 1024, 1024, 0, c.in[9] + l * 384, c.in[17] + l * 256, c.in[19] + l * 384, c.bfp(WS_WOUT) + (size_t)l * 1024 * 1024, r, 32); continue; } r -= I_OUT;
        if (r < I_GU) { p0_item(c, c.in[22] + (size_t)l * 1024 * DFF, c.in[23] + (size_t)l * 1024 * DFF, 1024, DFF, 2, c.in[21] + l * 1024, nullptr, nullptr, c.bfp(WS_WGU) + (size_t)l * 5632 * 1024, r, 176); continue; } r -= I_GU;
        if (r < I_DN) { p0_item(c, c.in[24] + (size_t)l * DFF * 1024, nullptr, DFF, 1024, 0, nullptr, nullptr, nullptr, c.bfp(WS_WDN) + (size_t)l * 1024 * DFF, r, 32); continue; } r -= I_DN;
        if (r < I_PG) { p0_item(c, c.in[26] + (size_t)l * 1024 * 1024, nullptr, 1024, 1024, 0, c.in[25] + l * 1024, nullptr, nullptr, c.bfp(WS_WPG) + (size_t)l * 1024 * 1024, r, 32); continue; } r -= I_PG;
        p0_item(c, c.in[28] + (size_t)l * PLE * 1024, nullptr, PLE, 1024, 0, nullptr, nullptr, nullptr, c.bfp(WS_WPP) + (size_t)l * 1024 * PLE, r, 32);
    }
    { float* rs0 = c.rs(RS_IN0); bf16_t* hb = c.bfp(WS_Y);
      for (int m = gw; m < MTOK; m += NGW) { const f32x4* xr = (const f32x4*)(c.in[0] + (size_t)m * DM) + c.lane; float s = 0.f; u32x2* o = (u32x2*)(hb + (size_t)m * DM) + c.lane;
#pragma unroll
          for (int j = 0; j < 4; ++j) { const f32x4 v = xr[64 * j]; s += (v[0] * v[0] + v[1] * v[1]) + (v[2] * v[2] + v[3] * v[3]); u32x2 w; w.x = pk2(v[0], v[1]); w.y = pk2(v[2], v[3]); o[64 * j] = w; }
          s = wave_sum64(s); if (c.lane == 0) rs0[m] = s; } }
    { const f32x4* p4 = (const f32x4*)c.in[1]; u32x4* o = (u32x4*)c.bfp(WS_PB); const int n8 = NLAYER * MTOK * PLE / 8;
      for (int i = gt; i < n8; i += NGT) { const f32x4 a = p4[2 * i], b = p4[2 * i + 1]; u32x4 w; w.x = pk2(a[0], a[1]); w.y = pk2(a[2], a[3]); w.z = pk2(b[0], b[1]); w.w = pk2(b[2], b[3]); o[i] = w; } }
}

constexpr int SP = 272;
constexpr int O_XT = 0, O_BM = O_XT + 64 * SP, O_BWT = O_BM + 128 * SP, O_CM = O_BWT + 128 * SP, O_PREV = O_CM + 128 * SP, O_FL = O_PREV + 64 * SP;
static_assert(O_FL + 2048 <= LDS_BYTES, "ssd lds");
DEV void ssd_unit(const Ctx& c, int layer, int b, int h) {
    const lptr L = c.L; const int tid = c.tid, lane = c.lane, w = c.wave, r16 = lane & 15, g4 = lane >> 4;
    const int grp = h / 3;
    const bf16_t* proj = c.bfp(WS_PROJ); const float* side = (const float*)(c.ws + WS_SIDE); bf16_t* ybuf = c.bfp(WS_Y);
    float* rss = c.rs(RS_SSD + layer);
    const float* cw = c.in[4] + (size_t)layer * 4 * 896; const float* cb = c.in[5] + (size_t)layer * 896;
    const float Aneg = -__expf(c.in[7][layer * 6 + h]), dtb = c.in[6][layer * 6 + h], Dh = c.in[8][layer * 6 + h];
    LAS float* dt_s = (LAS float*)(L + O_FL); LAS float* acs_s = dt_s + 128;
    f32x4 S[4];
#pragma unroll
    for (int i = 0; i < 4; ++i) S[i] = (f32x4){0.f, 0.f, 0.f, 0.f};
    for (int ch = 0; ch < 16; ++ch) {
        const int row0 = b * SEQ + ch * 128;
        if (w == 0) {
            const int l0 = 2 * lane;
            const float d0 = softplusf_(side[(size_t)(row0 + l0) * 16 + h] + dtb), d1 = softplusf_(side[(size_t)(row0 + l0 + 1) * 16 + h] + dtb);
            const float a0 = Aneg * d0, a1 = Aneg * d1; float s = a0 + a1;
#pragma unroll
            for (int o = 1; o < 64; o <<= 1) { const float t = __shfl_up(s, o); if (lane >= o) s += t; }
            dt_s[l0] = d0; dt_s[l0 + 1] = d1; acs_s[l0] = s - a1; acs_s[l0 + 1] = s;
        }
#pragma unroll
        for (int i = 0; i < 4; ++i)
#pragma unroll
            for (int r = 0; r < 4; ++r) { const int p = 16 * (w & 3) + 4 * g4 + r, n = 16 * (4 * (w >> 2) + i) + r16; *(LAS unsigned short*)(L + O_PREV + p * SP + n * 2) = (unsigned short)f2bf(S[i][r]); }
        WGBAR();
        const float total = acs_s[127];
        for (int it = tid; it < 640; it += 512) {
            const int cgi = it % 40, t0 = (it / 40) * 8;
            int col, cidx;
            if (cgi < 8) { col = C_X + h * 64 + cgi * 8; cidx = h * 64 + cgi * 8; }
            else if (cgi < 24) { col = C_B + grp * 128 + (cgi - 8) * 8; cidx = 384 + grp * 128 + (cgi - 8) * 8; }
            else { col = C_C + grp * 128 + (cgi - 24) * 8; cidx = 640 + grp * 128 + (cgi - 24) * 8; }
            float wk[4][8], bs[8];
#pragma unroll
            for (int k = 0; k < 4; ++k) { const f32x4 a = *(const f32x4*)(cw + k * 896 + cidx), bq = *(const f32x4*)(cw + k * 896 + cidx + 4);
                wk[k][0] = a[0]; wk[k][1] = a[1]; wk[k][2] = a[2]; wk[k][3] = a[3]; wk[k][4] = bq[0]; wk[k][5] = bq[1]; wk[k][6] = bq[2]; wk[k][7] = bq[3]; }
            { const f32x4 a = *(const f32x4*)(cb + cidx), bq = *(const f32x4*)(cb + cidx + 4); bs[0] = a[0]; bs[1] = a[1]; bs[2] = a[2]; bs[3] = a[3]; bs[4] = bq[0]; bs[5] = bq[1]; bs[6] = bq[2]; bs[7] = bq[3]; }
            float x0[8], x1[8], x2[8], x3[8];
            const int sp0 = ch * 128 + t0;
            const bf16_t* src = proj + (size_t)(b * SEQ + sp0) * NPROJ + col;
            { const u32x4 zz = (u32x4){0u, 0u, 0u, 0u};
              unpack8(sp0 >= 3 ? *(const u32x4*)(src - 3 * NPROJ) : zz, x0); unpack8(sp0 >= 2 ? *(const u32x4*)(src - 2 * NPROJ) : zz, x1); unpack8(sp0 >= 1 ? *(const u32x4*)(src - 1 * NPROJ) : zz, x2); }
#pragma unroll
            for (int i = 0; i < 8; ++i) {
                unpack8(*(const u32x4*)(src + (size_t)i * NPROJ), x3);
                const int l = t0 + i; float v[8];
#pragma unroll
                for (int j = 0; j < 8; ++j) { const float a = bs[j] + wk[0][j] * x0[j] + wk[1][j] * x1[j] + wk[2][j] * x2[j] + wk[3][j] * x3[j]; v[j] = siluf_(a); }
                if (cgi < 8) {
#pragma unroll
                    for (int j = 0; j < 8; ++j) *(LAS unsigned short*)(L + O_XT + (cgi * 8 + j) * SP + l * 2) = (unsigned short)f2bf(v[j]);
                } else if (cgi < 24) {
                    const int n0 = (cgi - 8) * 8; const float wl = dt_s[l] * __expf(total - acs_s[l]);
                    u32x4 o; o.x = pk2(v[0], v[1]); o.y = pk2(v[2], v[3]); o.z = pk2(v[4], v[5]); o.w = pk2(v[6], v[7]);
                    *(LAS u32x4*)(L + O_BM + l * SP + n0 * 2) = o;
#pragma unroll
                    for (int j = 0; j < 8; ++j) *(LAS unsigned short*)(L + O_BWT + (n0 + j) * SP + l * 2) = (unsigned short)f2bf(v[j] * wl);
                } else {
                    const int n0 = (cgi - 24) * 8;
                    u32x4 o; o.x = pk2(v[0], v[1]); o.y = pk2(v[2], v[3]); o.z = pk2(v[4], v[5]); o.w = pk2(v[6], v[7]);
                    *(LAS u32x4*)(L + O_CM + l * SP + n0 * 2) = o;
                }
#pragma unroll
                for (int j = 0; j < 8; ++j) { x0[j] = x1[j]; x1[j] = x2[j]; x2[j] = x3[j]; }
            }
        }
        WGBAR();
        bf16x8 ca[4];
#pragma unroll
        for (int ks = 0; ks < 4; ++ks) ca[ks] = ldsA(L + O_CM + (16 * w + r16) * SP + (32 * ks + 8 * g4) * 2);
        f32x4 Gt[8];
#pragma unroll
        for (int ct = 0; ct < 8; ++ct) { Gt[ct] = (f32x4){0.f, 0.f, 0.f, 0.f};
#pragma unroll
            for (int ks = 0; ks < 4; ++ks) Gt[ct] = MFMA16(ca[ks], ldsA(L + O_BM + (16 * ct + r16) * SP + (32 * ks + 8 * g4) * 2), Gt[ct]); }
        WGBAR();
        { const f32x4 al = *(const LAS f32x4*)(acs_s + 16 * w + 4 * g4);
#pragma unroll
          for (int ct = 0; ct < 8; ++ct) { const int s = 16 * ct + r16; const float as = acs_s[s], ds = dt_s[s];
#pragma unroll
              for (int r = 0; r < 4; ++r) { const int l = 16 * w + 4 * g4 + r; const float v = (s <= l) ? Gt[ct][r] * __expf(al[r] - as) * ds : 0.f;
                  *(LAS unsigned short*)(L + O_BM + l * SP + s * 2) = (unsigned short)f2bf(v); } } }
        WGBAR();
        f32x4 Y[4];
#pragma unroll
        for (int pt = 0; pt < 4; ++pt) { Y[pt] = (f32x4){0.f, 0.f, 0.f, 0.f};
#pragma unroll
            for (int ks = 0; ks < 4; ++ks) Y[pt] = MFMA16(ca[ks], ldsA(L + O_PREV + (16 * pt + r16) * SP + (32 * ks + 8 * g4) * 2), Y[pt]); }
        { const f32x4 al = *(const LAS f32x4*)(acs_s + 16 * w + 4 * g4);
#pragma unroll
          for (int r = 0; r < 4; ++r) { const float e = __expf(al[r]);
#pragma unroll
              for (int pt = 0; pt < 4; ++pt) Y[pt][r] *= e; } }
#pragma unroll
        for (int ks = 0; ks < 4; ++ks) { const bf16x8 sa = ldsA(L + O_BM + (16 * w + r16) * SP + (32 * ks + 8 * g4) * 2);
#pragma unroll
            for (int pt = 0; pt < 4; ++pt) Y[pt] = MFMA16(sa, ldsA(L + O_XT + (16 * pt + r16) * SP + (32 * ks + 8 * g4) * 2), Y[pt]); }
        { float ss[4] = {0.f, 0.f, 0.f, 0.f};
#pragma unroll
          for (int pt = 0; pt < 4; ++pt) { const int p = 16 * pt + r16;
              const u32x2 xw = *(const LAS u32x2*)(L + O_XT + p * SP + (16 * w + 4 * g4) * 2);
              const float xs[4] = {bflo(xw.x), bfhi(xw.x), bflo(xw.y), bfhi(xw.y)};
#pragma unroll
              for (int r = 0; r < 4; ++r) { const int l = 16 * w + 4 * g4 + r; const size_t row = (size_t)(row0 + l);
                  const float z = bf2f(proj[row * NPROJ + C_Z + h * 64 + p]); const float yo = (Y[pt][r] + Dh * xs[r]) * siluf_(z);
                  ybuf[row * DM + h * 64 + p] = (bf16_t)f2bf(yo); ss[r] += yo * yo; } }
#pragma unroll
          for (int r = 0; r < 4; ++r) { float s = ss[r]; s += __shfl_xor(s, 1); s += __shfl_xor(s, 2); s += __shfl_xor(s, 4); s += __shfl_xor(s, 8);
              if (r16 == 0) unsafeAtomicAdd(rss + row0 + 16 * w + 4 * g4 + r, s); } }
        { const float dec = __expf(total);
#pragma unroll
          for (int i = 0; i < 4; ++i) S[i] *= dec;
#pragma unroll
          for (int ks = 0; ks < 4; ++ks) { const bf16x8 xa = ldsA(L + O_XT + (16 * (w & 3) + r16) * SP + (32 * ks + 8 * g4) * 2);
#pragma unroll
              for (int i = 0; i < 4; ++i) S[i] = MFMA16(xa, ldsA(L + O_BWT + (16 * (4 * (w >> 2) + i) + r16) * SP + (32 * ks + 8 * g4) * 2), S[i]); } }
        WGBAR();
    }
}

constexpr int LP = 144;
constexpr int O_LX = 0, O_WA = O_LX + 128 * LP, O_WX = O_WA + 64 * LP, O_XF = O_WX + 64 * LP, O_AS = O_XF + 32768, O_US = O_AS + 32768, O_SEG = O_US + 32768;
static_assert(O_SEG + 4096 <= LDS_BYTES, "lru lds");
DEV void lru_unit(const Ctx& c, int layer, int b, int g) {
    const lptr L = c.L; const int tid = c.tid, lane = c.lane, w = c.wave, r16 = lane & 15, g4 = lane >> 4;
    const bf16_t* proj = c.bfp(WS_PROJ); bf16_t* ybuf = c.bfp(WS_Y); float* rss = c.rs(RS_LRU + layer);
    const float* cw = c.in[10] + (size_t)layer * 4 * 256; const float* cb = c.in[11] + (size_t)layer * 256;
    const float* wa = c.in[12] + ((size_t)layer * 4 + g) * 4096; const float* wx = c.in[14] + ((size_t)layer * 4 + g) * 4096;
    LAS float* xf = (LAS float*)(L + O_XF); LAS float* a_s = (LAS float*)(L + O_AS); LAS float* u_s = (LAS float*)(L + O_US);
    LAS float* segH = (LAS float*)(L + O_SEG); LAS float* segP = segH + 512;
    for (int e = tid; e < 4096; e += 512) { const int i = e >> 6, j = e & 63;
        *(LAS unsigned short*)(L + O_WA + j * LP + i * 2) = (unsigned short)f2bf(wa[e]); *(LAS unsigned short*)(L + O_WX + j * LP + i * 2) = (unsigned short)f2bf(wx[e]); }
    float ba[4], bx[4], spl[4];
#pragma unroll
    for (int jt = 0; jt < 4; ++jt) { const int ch = 64 * g + 16 * jt + r16; ba[jt] = c.in[13][layer * 256 + ch]; bx[jt] = c.in[15][layer * 256 + ch]; spl[jt] = softplusf_(-c.in[16][layer * 256 + ch]); }
    float carry = 0.f;
    const int cgi = tid & 7, t0 = (tid >> 3) * 2;
    float wk[4][8], bs[8];
#pragma unroll
    for (int k = 0; k < 4; ++k) { const f32x4 a = *(const f32x4*)(cw + k * 256 + 64 * g + cgi * 8), bq = *(const f32x4*)(cw + k * 256 + 64 * g + cgi * 8 + 4);
        wk[k][0] = a[0]; wk[k][1] = a[1]; wk[k][2] = a[2]; wk[k][3] = a[3]; wk[k][4] = bq[0]; wk[k][5] = bq[1]; wk[k][6] = bq[2]; wk[k][7] = bq[3]; }
    { const f32x4 a = *(const f32x4*)(cb + 64 * g + cgi * 8), bq = *(const f32x4*)(cb + 64 * g + cgi * 8 + 4); bs[0] = a[0]; bs[1] = a[1]; bs[2] = a[2]; bs[3] = a[3]; bs[4] = bq[0]; bs[5] = bq[1]; bs[6] = bq[2]; bs[7] = bq[3]; }
    for (int ch = 0; ch < 16; ++ch) {
        const int row0 = b * SEQ + ch * 128;
        { const int sp0 = ch * 128 + t0; const bf16_t* src = proj + (size_t)(b * SEQ + sp0) * NPROJ + C_LX + 64 * g + cgi * 8;
          float x0[8], x1[8], x2[8], x3[8], x4[8]; const u32x4 zz = (u32x4){0u, 0u, 0u, 0u};
          unpack8(sp0 >= 3 ? *(const u32x4*)(src - 3 * NPROJ) : zz, x0); unpack8(sp0 >= 2 ? *(const u32x4*)(src - 2 * NPROJ) : zz, x1); unpack8(sp0 >= 1 ? *(const u32x4*)(src - 1 * NPROJ) : zz, x2);
          unpack8(*(const u32x4*)(src), x3); unpack8(*(const u32x4*)(src + NPROJ), x4);
          float v0[8], v1[8];
#pragma unroll
          for (int j = 0; j < 8; ++j) { v0[j] = bs[j] + wk[0][j] * x0[j] + wk[1][j] * x1[j] + wk[2][j] * x2[j] + wk[3][j] * x3[j]; v1[j] = bs[j] + wk[0][j] * x1[j] + wk[1][j] * x2[j] + wk[2][j] * x3[j] + wk[3][j] * x4[j]; }
          u32x4 o; o.x = pk2(v0[0], v0[1]); o.y = pk2(v0[2], v0[3]); o.z = pk2(v0[4], v0[5]); o.w = pk2(v0[6], v0[7]); *(LAS u32x4*)(L + O_LX + t0 * LP + cgi * 16) = o;
          o.x = pk2(v1[0], v1[1]); o.y = pk2(v1[2], v1[3]); o.z = pk2(v1[4], v1[5]); o.w = pk2(v1[6], v1[7]); *(LAS u32x4*)(L + O_LX + (t0 + 1) * LP + cgi * 16) = o;
          *(LAS f32x4*)(xf + t0 * 64 + cgi * 8) = (f32x4){v0[0], v0[1], v0[2], v0[3]}; *(LAS f32x4*)(xf + t0 * 64 + cgi * 8 + 4) = (f32x4){v0[4], v0[5], v0[6], v0[7]};
          *(LAS f32x4*)(xf + (t0 + 1) * 64 + cgi * 8) = (f32x4){v1[0], v1[1], v1[2], v1[3]}; *(LAS f32x4*)(xf + (t0 + 1) * 64 + cgi * 8 + 4) = (f32x4){v1[4], v1[5], v1[6], v1[7]}; }
        WGBAR();
        { bf16x8 xa[2];
#pragma unroll
          for (int ks = 0; ks < 2; ++ks) xa[ks] = ldsA(L + O_LX + (16 * w + r16) * LP + (32 * ks + 8 * g4) * 2);
#pragma unroll
          for (int jt = 0; jt < 4; ++jt) { f32x4 R = (f32x4){0.f, 0.f, 0.f, 0.f}, I = R;
#pragma unroll
              for (int ks = 0; ks < 2; ++ks) { R = MFMA16(xa[ks], ldsA(L + O_WA + (16 * jt + r16) * LP + (32 * ks + 8 * g4) * 2), R); I = MFMA16(xa[ks], ldsA(L + O_WX + (16 * jt + r16) * LP + (32 * ks + 8 * g4) * 2), I); }
#pragma unroll
              for (int r = 0; r < 4; ++r) { const int t = 16 * w + 4 * g4 + r, j = 16 * jt + r16;
                  const float rg = sigmoidf_(R[r] + ba[jt]), ig = sigmoidf_(I[r] + bx[jt]); const float la = -8.f * rg * spl[jt];
                  const float a = __expf(la), mult = sqrtf(fmaxf(-expm1f(2.f * la), 0.f));
                  a_s[t * 64 + j] = a; u_s[t * 64 + j] = mult * ig * xf[t * 64 + j]; } } }
        WGBAR();
        { float hh = 0.f, pp = 1.f;
#pragma unroll
          for (int i = 0; i < 16; ++i) { const int t = 16 * w + i; const float a = a_s[t * 64 + lane], u = u_s[t * 64 + lane]; hh = a * hh + u; pp *= a; u_s[t * 64 + lane] = hh; a_s[t * 64 + lane] = pp; }
          segH[w * 64 + lane] = hh; segP[w * 64 + lane] = pp; }
        WGBAR();
        { float cin = carry, call = carry;
#pragma unroll
          for (int q = 0; q < 8; ++q) { const float sh = segH[q * 64 + lane], sp = segP[q * 64 + lane]; call = sp * call + sh; if (q < w) cin = call; }
          carry = call;
#pragma unroll 4
          for (int i = 0; i < 16; ++i) { const int t = 16 * w + i; const size_t row = (size_t)(row0 + t);
              const float hv = u_s[t * 64 + lane] + a_s[t * 64 + lane] * cin;
              const float gt = bf2f(proj[row * NPROJ + C_LG + 64 * g + lane]); const float yo = hv * gelu_tanhf_(gt);
              ybuf[row * DM + 384 + 64 * g + lane] = (bf16_t)f2bf(yo);
              const float s = wave_sum64(yo * yo); if (lane == 0) unsafeAtomicAdd(rss + row, s); } }
        WGBAR();
    }
}

constexpr int KP = 144;
constexpr int O_NB = 0, O_KV = 8192, KVB = 64 * KP  , O_RED = O_KV + 4 * KVB;
static_assert(O_RED + 256 <= LDS_BYTES, "fox lds");
DEV bf16x8 vtr8(lptr p0, lptr p1) {
    const v4i16_t lo = __builtin_amdgcn_ds_read_tr16_b64_v4i16((LAS v4i16_t*)p0), hi = __builtin_amdgcn_ds_read_tr16_b64_v4i16((LAS v4i16_t*)p1);
    return (bf16x8){lo[0], lo[1], lo[2], lo[3], hi[0], hi[1], hi[2], hi[3]};
}
DEV void fox_qblock(const Ctx& c, int layer, int b, int h, int qb) {
    const lptr L = c.L; const int tid = c.tid, lane = c.lane, w = c.wave, r16 = lane & 15, g4 = lane >> 4;
    const bf16_t* proj = c.bfp(WS_PROJ); bf16_t* ybuf = c.bfp(WS_Y); float* rss = c.rs(RS_FOX + layer);
    const LAS float* nb = (const LAS float*)(L + O_NB);
    const int q0 = qb * 256 + w * 32;
    const size_t rowb = (size_t)b * SEQ;
    constexpr float C1 = 0.125f * 1.4426950408889634f;
    bf16x8 qf[2][2];
#pragma unroll
    for (int qt = 0; qt < 2; ++qt)
#pragma unroll
        for (int ks = 0; ks < 2; ++ks) qf[qt][ks] = *(const bf16x8*)(proj + (rowb + q0 + 16 * qt + r16) * NPROJ + C_Q + h * 64 + 32 * ks + 8 * g4);
    f32x4 o[4][2];
#pragma unroll
    for (int dt = 0; dt < 4; ++dt) { o[dt][0] = (f32x4){0.f, 0.f, 0.f, 0.f}; o[dt][1] = o[dt][0]; }
    float mrun[2] = {-INFINITY, -INFINITY}, lsum[2] = {0.f, 0.f};
    const int NT = 4 * (qb + 1);
    const int srow = tid >> 3, sch = tid & 7;
    const bf16_t* ksrc = proj + (rowb + srow) * NPROJ + C_K + h * 64 + sch * 8;
    const bf16_t* vsrc = proj + (rowb + srow) * NPROJ + C_V + h * 64 + sch * 8;
    u32x4 kreg = *(const u32x4*)ksrc, vreg = *(const u32x4*)vsrc;
    *(LAS u32x4*)(L + O_KV + srow * KP + sch * 16) = kreg; *(LAS u32x4*)(L + O_KV + KVB + srow * KP + sch * 16) = vreg;
    WGBAR();
    for (int t = 0; t < NT; ++t) {
        const int buf = t & 1; const lptr Kb = L + O_KV + buf * 2 * KVB, Vb = Kb + KVB;
        if (t + 1 < NT) { kreg = *(const u32x4*)(ksrc + (size_t)(t + 1) * 64 * NPROJ); vreg = *(const u32x4*)(vsrc + (size_t)(t + 1) * 64 * NPROJ); }
        const int kv0 = t * 64;
        if (kv0 <= q0 + 31) {
            f32x4 s[4][2];
#pragma unroll
            for (int kt = 0; kt < 4; ++kt) { s[kt][0] = (f32x4){0.f, 0.f, 0.f, 0.f}; s[kt][1] = s[kt][0];
#pragma unroll
                for (int ks = 0; ks < 2; ++ks) { const bf16x8 ka = ldsA(Kb + (16 * kt + r16) * KP + (32 * ks + 8 * g4) * 2);
                    s[kt][0] = MFMA16(ka, qf[0][ks], s[kt][0]); s[kt][1] = MFMA16(ka, qf[1][ks], s[kt][1]); } }
            const bool diag = (kv0 + 63 > q0);
            float mnew[2] = {mrun[0], mrun[1]};
#pragma unroll
            for (int kt = 0; kt < 4; ++kt) { const f32x4 bias = *(const LAS f32x4*)(nb + kv0 + 16 * kt + 4 * g4);
#pragma unroll
                for (int qt = 0; qt < 2; ++qt)
#pragma unroll
                    for (int r = 0; r < 4; ++r) { float v = s[kt][qt][r] * C1 + bias[r];
                        if (diag) { const int kv = kv0 + 16 * kt + 4 * g4 + r, q = q0 + 16 * qt + r16; if (kv > q) v = -INFINITY; }
                        s[kt][qt][r] = v; mnew[qt] = fmaxf(mnew[qt], v); } }
            float alpha[2];
#pragma unroll
            for (int qt = 0; qt < 2; ++qt) { float m = mnew[qt]; m = fmaxf(m, __shfl_xor(m, 16)); m = fmaxf(m, __shfl_xor(m, 32)); mnew[qt] = m;
                alpha[qt] = exp2f(mrun[qt] - m); mrun[qt] = m; }
            float ps[2] = {0.f, 0.f};
#pragma unroll
            for (int kt = 0; kt < 4; ++kt)
#pragma unroll
                for (int qt = 0; qt < 2; ++qt)
#pragma unroll
                    for (int r = 0; r < 4; ++r) { const float p = exp2f(s[kt][qt][r] - mnew[qt]); s[kt][qt][r] = p; ps[qt] += p; }
#pragma unroll
            for (int qt = 0; qt < 2; ++qt) { lsum[qt] = lsum[qt] * alpha[qt] + ps[qt];
#pragma unroll
                for (int dt = 0; dt < 4; ++dt) o[dt][qt] *= alpha[qt]; }
#pragma unroll
            for (int k2 = 0; k2 < 2; ++k2) {
                bf16x8 pb[2];
#pragma unroll
                for (int qt = 0; qt < 2; ++qt) { const f32x4 a = s[2 * k2][qt], bq = s[2 * k2 + 1][qt];
                    const u32x4 wv = (u32x4){cvt_pk_bf16(a[0], a[1]), cvt_pk_bf16(a[2], a[3]), cvt_pk_bf16(bq[0], bq[1]), cvt_pk_bf16(bq[2], bq[3])}; pb[qt] = __builtin_bit_cast(bf16x8, wv); }
#pragma unroll
                for (int dt = 0; dt < 4; ++dt) {
                    const lptr va = Vb + (32 * k2 + 4 * g4 + (r16 >> 2)) * KP + (16 * dt + 4 * (r16 & 3)) * 2;
                    const bf16x8 vf = vtr8(va, va + 16 * KP);
                    o[dt][0] = MFMA16(vf, pb[0], o[dt][0]); o[dt][1] = MFMA16(vf, pb[1], o[dt][1]); }
            }
        }
        if (t + 1 < NT) { const lptr Kn = L + O_KV + (buf ^ 1) * 2 * KVB; *(LAS u32x4*)(Kn + srow * KP + sch * 16) = kreg; *(LAS u32x4*)(Kn + KVB + srow * KP + sch * 16) = vreg; }
        WGBAR();
    }
#pragma unroll
    for (int qt = 0; qt < 2; ++qt) { float l = lsum[qt]; l += __shfl_xor(l, 16); l += __shfl_xor(l, 32); const float rl = 1.f / l;
        const size_t row = rowb + q0 + 16 * qt + r16; float ss = 0.f;
#pragma unroll
        for (int dt = 0; dt < 4; ++dt) { const f32x4 v = o[dt][qt] * rl; u32x2 wv; wv.x = cvt_pk_bf16(v[0], v[1]); wv.y = cvt_pk_bf16(v[2], v[3]);
            *(u32x2*)(ybuf + row * DM + 640 + h * 64 + 16 * dt + 4 * g4) = wv; ss += (v[0] * v[0] + v[1] * v[1]) + (v[2] * v[2] + v[3] * v[3]); }
        ss += __shfl_xor(ss, 16); ss += __shfl_xor(ss, 32);
        if (g4 == 0) unsafeAtomicAdd(rss + row, ss); }
}
DEV void fox_unit(const Ctx& c, int layer, int b, int h, int pair) {
    const lptr L = c.L; const int tid = c.tid, lane = c.lane, w = c.wave;
    const float* side = (const float*)(c.ws + WS_SIDE); const float bf = c.in[18][layer * 6 + h];
    LAS float* nb = (LAS float*)(L + O_NB); LAS float* red = (LAS float*)(L + O_RED);
    { float v[4]; float run = 0.f;
#pragma unroll
      for (int i = 0; i < 4; ++i) { const float x = side[((size_t)b * SEQ + 4 * tid + i) * 16 + 6 + h] + bf; run += -softplusf_(-x); v[i] = run; }
      float s = run;
#pragma unroll
      for (int o = 1; o < 64; o <<= 1) { const float t = __shfl_up(s, o); if (lane >= o) s += t; }
      if (lane == 63) red[w] = s;
      WGBAR();
      float base = s - run;
#pragma unroll
      for (int q = 0; q < 8; ++q) if (q < w) base += red[q];
#pragma unroll
      for (int i = 0; i < 4; ++i) nb[4 * tid + i] = -1.4426950408889634f * (base + v[i]);
      WGBAR(); }
    fox_qblock(c, layer, b, h, 7 - pair);
    fox_qblock(c, layer, b, h, pair);
    WGBAR();
}

#ifndef MXMASK
#define MXMASK 7
#endif
DEV Ctx relaunder(const Ctx& c0) { Ctx c = c0; int t = threadIdx.x; asm volatile("" : "+v"(t)); c.tid = t; c.lane = t & 63; c.wave = __builtin_amdgcn_readfirstlane(t >> 6);
    unsigned char* w = c0.ws; asm volatile("" : "+s"(w)); c.ws = w; float* o = c0.out; asm volatile("" : "+s"(o)); c.out = o; return c; }
DEV void mixer_phase(const Ctx& c0, int layer) {
    constexpr int N_SSD = NB * 6, N_LRU = NB * 4, N_FOX = NB * 6 * 4, N_ALL = N_SSD + N_LRU + N_FOX;
    for (int u = c0.bid; u < N_ALL; u += c0.G) {
        const Ctx c = relaunder(c0);
        if (u < N_SSD) { if (MXMASK & 1) ssd_unit(c, layer, u / 6, u % 6); }
        else if (u < N_SSD + N_LRU) { const int v = u - N_SSD; if (MXMASK & 2) lru_unit(c, layer, v >> 2, v & 3); }
        else { const int v = u - N_SSD - N_LRU; if (MXMASK & 4) fox_unit(c, layer, v / 24, (v % 24) >> 2, v & 3); }
    }
}
DEV void ynorm_phase(const Ctx& c, int layer) {
    u32x4* y = (u32x4*)c.bfp(WS_Y); const float* r0 = c.rs(RS_SSD + layer); const float* r1 = c.rs(RS_LRU + layer); const float* r2 = c.rs(RS_FOX + layer);
    const int gt = c.bid * 512 + c.tid, NGT = c.G * 512;
    for (int i = gt; i < MTOK * 128; i += NGT) { const int row = i >> 7, c8 = i & 127;
        const float sc = (c8 < 48) ? rsqrtf(r0[row] * (1.f / 384.f) + EPSN) : (c8 < 80 ? rsqrtf(r1[row] * (1.f / 256.f) + EPSN) : rsqrtf(r2[row] * (1.f / 384.f) + EPSN));
        float v[8]; unpack8(y[i], v); u32x4 o; o.x = pk2(v[0] * sc, v[1] * sc); o.y = pk2(v[2] * sc, v[3] * sc); o.z = pk2(v[4] * sc, v[5] * sc); o.w = pk2(v[6] * sc, v[7] * sc); y[i] = o; }
}
DEV void final_phase(const Ctx& c) {
    f32x4* h = (f32x4*)c.out; const float* rs = c.rs(RS_FINAL); const f32x4* g = (const f32x4*)c.in[29];
    const int gt = c.bid * 512 + c.tid, NGT = c.G * 512;
    for (int i = gt; i < MTOK * 256; i += NGT) { const int row = i >> 8, c4 = i & 255; const float sc = rsqrtf(rs[row] * (1.f / 1024.f) + EPSN); h[i] = h[i] * sc * g[c4]; }
}

constexpr int N_PHASES = 16;
#ifndef PHMASK
#define PHMASK 511
#endif
__global__ void __launch_bounds__(512, 2) trunk_fwd(Args args) {
    extern __shared__ __attribute__((aligned(16))) unsigned char lds[];
    cg::grid_group grid = cg::this_grid();
    Ctx c;
    c.out = args.out; c.ws = args.ws; c.L = (lptr)lds; c.tid = threadIdx.x; c.lane = c.tid & 63; c.wave = __builtin_amdgcn_readfirstlane(c.tid >> 6); c.G = gridDim.x; c.bid = blockIdx.x;
    const Ctx cbase = c;
    for (int ph = args.ph_lo; ph < args.ph_hi; ++ph) {
        c = relaunder(cbase);
        if (ph == 0) { if (PHMASK & 1) p0_prologue(c); }
        else if (ph == N_PHASES - 1) { if (PHMASK & 2) final_phase(c); }
        else {
            const int l = (ph - 1) / 7, sp = (ph - 1) % 7;
            if (sp == 0) { if (PHMASK & 4) {
                pg8::Gemm g{l == 0 ? c.bfp(WS_Y) : c.bfp(WS_Y), c.bfp(WS_WIN) + (size_t)l * NPROJ * 1024, MTOK, NPROJ, 1024}; pg8::StaticOrder S; S.init(MTOK, NPROJ, c.G, c.bid);
                EpiProj E{c.bfp(WS_PROJ), c.rs(l == 0 ? RS_IN0 : RS_IN1), (float*)(c.ws + WS_SIDE)};
                pg8::gemm_phase<EpiProj, pg8::StaticOrder, true, true>((PG8_LAS unsigned char*)lds, g, S, E); }
            } else if (sp == 1) { if (PHMASK & 8) mixer_phase(c, l); }
            else if (sp == 2) {
                if (PHMASK & 16) {ynorm_phase(c, l);
                int kpp = PLE; asm volatile("" : "+s"(kpp));
                pg8::Gemm g{c.bfp(WS_PB) + (size_t)l * MTOK * PLE, c.bfp(WS_WPP) + (size_t)l * 1024 * PLE, MTOK, 1024, kpp}; pg8::StaticOrder S; S.init(MTOK, 1024, c.G, c.bid);
                EpiPP E{c.bfp(WS_PP)};
                pg8::gemm_phase<EpiPP, pg8::StaticOrder, true, true>((PG8_LAS unsigned char*)lds, g, S, E); }
            } else if (sp == 3) { if (PHMASK & 32) {
                pg8::Gemm g{c.bfp(WS_Y), c.bfp(WS_WOUT) + (size_t)l * 1024 * 1024, MTOK, 1024, 1024}; pg8::StaticOrder S; S.init(MTOK, 1024, c.G, c.bid);
                EpiResid E{l == 0 ? c.in[0] : c.out, c.out, c.bfp(WS_HBA), c.rs(RS_N2 + l)};
                pg8::gemm_phase<EpiResid, pg8::StaticOrder, true, true>((PG8_LAS unsigned char*)lds, g, S, E); }
            } else if (sp == 4) { if (PHMASK & 64) {
                pg8::Gemm g{c.bfp(WS_HBA), c.bfp(WS_WGU) + (size_t)l * 5632 * 1024, MTOK, 5632, 1024}; pg8::StaticOrder S; S.init(MTOK, 5632, c.G, c.bid);
                EpiSwiGLU E{c.bfp(WS_PROJ), c.rs(RS_N2 + l)};
                pg8::gemm_phase<EpiSwiGLU, pg8::StaticOrder, true, true>((PG8_LAS unsigned char*)lds, g, S, E); }
            } else if (sp == 5) { if (PHMASK & 128) {
                pg8::Gemm g{c.bfp(WS_PROJ), c.bfp(WS_WDN) + (size_t)l * 1024 * DFF, MTOK, 1024, DFF}; pg8::StaticOrder S; S.init(MTOK, 1024, c.G, c.bid);
                EpiResid E{c.out, c.out, c.bfp(WS_HBA), c.rs(RS_N3 + l)};
                pg8::gemm_phase<EpiResid, pg8::StaticOrder, true, true>((PG8_LAS unsigned char*)lds, g, S, E); }
            } else { if (PHMASK & 256) {
                pg8::Gemm g{c.bfp(WS_HBA), c.bfp(WS_WPG) + (size_t)l * 1024 * 1024, MTOK, 1024, 1024}; pg8::StaticOrder S; S.init(MTOK, 1024, c.G, c.bid);
                EpiPle E{c.out, c.bfp(WS_Y), c.bfp(WS_PP), c.in[27] + l * 1024, c.rs(RS_N3 + l), c.rs(l == 0 ? RS_IN1 : RS_FINAL)};
                pg8::gemm_phase<EpiPle, pg8::StaticOrder, true, true>((PG8_LAS unsigned char*)lds, g, S, E); }
            }
        }
        if (ph + 1 < args.ph_hi) grid.sync();
    }
}

#ifndef ONE_LAUNCH
#define ONE_LAUNCH 1
#endif
extern "C" void kernel_launch(void* const* d_in, const int* in_sizes, int n_in, void* d_out, int out_size, void* d_ws, size_t ws_size, hipStream_t stream) {
    static int grid = 0;
    if (grid == 0) {
        if (n_in != 30 || out_size != MTOK * DM || ws_size < WS_END) { fprintf(stderr, "kernel_launch: unexpected shapes (n_in %d out %d ws %zu)\n", n_in, out_size, ws_size); grid = -1; return; }
        int dev = 0, cus = 0, per_cu = 0;
        hipGetDevice(&dev); hipDeviceGetAttribute(&cus, hipDeviceAttributeMultiprocessorCount, dev);
        if (hipFuncSetAttribute((const void*)trunk_fwd, hipFuncAttributeMaxDynamicSharedMemorySize, LDS_BYTES) != hipSuccess) { fprintf(stderr, "kernel_launch: hipFuncSetAttribute failed\n"); grid = -1; return; }
        if (hipOccupancyMaxActiveBlocksPerMultiprocessor(&per_cu, (const void*)trunk_fwd, 512, LDS_BYTES) != hipSuccess || per_cu < 1) per_cu = 1;
        (void)hipGetLastError();
        grid = cus * (per_cu > 1 ? 1 : per_cu);
    }
    if (grid < 0) return;
    Args a{};
    for (int i = 0; i < 30; ++i) a.in[i] = (const float*)d_in[i];
    a.out = (float*)d_out; a.ws = (unsigned char*)d_ws;
#if ONE_LAUNCH
    a.ph_lo = 0; a.ph_hi = N_PHASES;
    void* kargs[] = {&a};
    hipError_t e = hipLaunchCooperativeKernel((const void*)trunk_fwd, dim3(grid), dim3(512), kargs, LDS_BYTES, stream);
    if (e != hipSuccess) fprintf(stderr, "cooperative launch failed: %s (grid %d)\n", hipGetErrorString(e), grid);
#else
    for (int ph = 0; ph < N_PHASES; ++ph) { a.ph_lo = ph; a.ph_hi = ph + 1; hipLaunchKernelGGL(trunk_fwd, dim3(grid), dim3(512), LDS_BYTES, stream, a); }
#endif
}
```

```cpp
#include <hip/hip_runtime.h>
#include <cstdio>
#include <cstdint>
namespace pg8 {
#define PG8_LAS __attribute__((address_space(3)))
typedef unsigned short bf16_t;
typedef short bf16x8 __attribute__((ext_vector_type(8)));
typedef float f32x4 __attribute__((ext_vector_type(4)));
typedef unsigned u32x4 __attribute__((ext_vector_type(4)));
constexpr int BM = 256, BK = 64, HALF = 128, HTB = HALF * BK * 2  , STAGE_BYTES = 8 * HTB, NXCD = 8, WGM = 8;

__host__ __device__ __forceinline__ int lds_byte(int r, int c) { const int st = (r >> 4) * 2 + (c >> 5), rr = r & 15, cc = c & 31, ob = rr * 64 + cc * 2; return st * 1024 + (ob ^ (((ob >> 9) & 1) << 5)); }
__host__ __device__ __forceinline__ void stage_rc(int b, int& R, int& C) { const int st = b / 1024, sb = b % 1024, swz = sb ^ (((sb >> 9) & 1) << 5); R = (st >> 1) * 16 + swz / 64; C = (st & 1) * 32 + (swz % 64) / 2; }
__host__ __device__ __forceinline__ int perm32(int rho) { const int n = rho >> 4, i = rho & 15; return 8 * (i >> 2) + 4 * n + (i & 3); }

struct Unit { int pm, pn; };
struct Gemm { const bf16_t* A; const bf16_t* Bt; int M, N, K; };

struct StaticOrder {
    int nM, nN, nwg, G, c;
    __host__ __device__ void init(int M, int N, int G_, int c_) { nM = M / BM; nN = N / BM; nwg = nM * nN; G = G_; c = c_; }
    __host__ __device__ bool next(int i, Unit& u) const {
        const long L = (long)i * G + c; if (L >= nwg) return false;
        int wgid = (int)L; { const int q = nwg / NXCD, r = nwg % NXCD, xcd = wgid % NXCD, off = wgid / NXCD; wgid = (xcd < r ? xcd * (q + 1) : r * (q + 1) + (xcd - r) * q) + off; }
        const int nig = WGM * nN, gid = wgid / nig, fm = gid * WGM, gsz = (nM - fm) < WGM ? (nM - fm) : WGM;
        u.pm = fm + ((wgid % nig) % gsz); u.pn = (wgid % nig) / gsz; return true;
    }
    __device__ __forceinline__ void a_ready(const Unit&) const {}
    __device__ __forceinline__ void done(const Unit&) const {}
};

__device__ __forceinline__ unsigned cvt_pk_bf16(float lo, float hi) { unsigned r; asm volatile("v_cvt_pk_bf16_f32 %0, %1, %2" : "=v"(r) : "v"(lo), "v"(hi)); return r; }
typedef float f32x2 __attribute__((ext_vector_type(2)));
__device__ __forceinline__ f32x2 gelu_pk(f32x2 v) {
    const f32x2 av = __builtin_elementwise_abs(v), d = av * 0.2316418882f + 1.0f;
    f32x2 t; t.x = __builtin_amdgcn_rcpf(d.x); t.y = __builtin_amdgcn_rcpf(d.y);
    f32x2 q = t * 0.5307027145f + (-0.7265760135f); q = q * t + 0.7107068705f; q = q * t + (-0.142248368f); q = q * t + 0.127414796f; q = q * t;
    const f32x2 s = (v * v) * (-0.72134752044f);
    f32x2 e; e.x = __builtin_amdgcn_exp2f(s.x); e.y = __builtin_amdgcn_exp2f(s.y);
    const f32x2 m = v * (q * e), r = v - m;
    f32x2 o; o.x = v.x < 0.f ? m.x : r.x; o.y = v.y < 0.f ? m.y : r.y; return o;
}

template <int ACT  > struct EpiBf16 {
    static constexpr bool PERM = true, AFTER_DRAIN = false; static_assert(ACT == 0 || ACT == 1, "EpiBf16: ACT is 0 (none) or 1 (gelu_pk)");
    bf16_t* O; int ldc; const float* bias; int split_cols; size_t split_stride; float scale0;
    __device__ __forceinline__ void operator()(const f32x4 (&acc)[2][2][4][2], const Unit& u, int wr, int wc, int fr, int fq) const {
        const int row0 = u.pm * BM + wr * 64 + fr; int colt = u.pn * BM; bf16_t* base = O;
        float sc = 1.f; if (split_cols) { const int t = colt / split_cols; base += (size_t)t * split_stride; colt -= t * split_cols; if (t == 0) sc = scale0; }
        const int col0 = colt + wc * 32 + 8 * fq, bcol0 = u.pn * BM + wc * 32 + 8 * fq;
        f32x4 bv[2][2];
#pragma unroll
        for (int bj = 0; bj < 2; ++bj)
#pragma unroll
            for (int n = 0; n < 2; ++n) bv[bj][n] = bias ? *(const f32x4*)(bias + bcol0 + bj * HALF + 4 * n) : (f32x4){0.f, 0.f, 0.f, 0.f};
#pragma unroll
        for (int ai = 0; ai < 2; ++ai)
#pragma unroll
            for (int m = 0; m < 4; ++m) { bf16_t* rowp = base + (size_t)(row0 + ai * HALF + m * 16) * ldc + col0;
#pragma unroll
                for (int bj = 0; bj < 2; ++bj) { f32x4 v0 = acc[ai][bj][m][0] + bv[bj][0], v1 = acc[ai][bj][m][1] + bv[bj][1];
                    if (ACT == 1) { f32x2 a = gelu_pk((f32x2){v0[0], v0[1]}), b = gelu_pk((f32x2){v0[2], v0[3]}), c = gelu_pk((f32x2){v1[0], v1[1]}), d = gelu_pk((f32x2){v1[2], v1[3]});
                        v0 = (f32x4){a.x, a.y, b.x, b.y}; v1 = (f32x4){c.x, c.y, d.x, d.y}; }
                    v0 = v0 * sc; v1 = v1 * sc; u32x4 w; w.x = cvt_pk_bf16(v0[0], v0[1]); w.y = cvt_pk_bf16(v0[2], v0[3]); w.z = cvt_pk_bf16(v1[0], v1[1]); w.w = cvt_pk_bf16(v1[2], v1[3]);
                    *(u32x4*)(rowp + bj * HALF) = w; } }
    }
};
template <class Epi, class Sched, bool ALIGN_EPI = false, bool SP2 = false>
__device__ __forceinline__ void gemm_phase(PG8_LAS unsigned char* lds, const Gemm g, const Sched& S, const Epi& E) {
    int tid_ = threadIdx.x; asm volatile("" : "+v"(tid_));
    const int tid = tid_, wid = __builtin_amdgcn_readfirstlane(tid >> 6), lane = tid & 63, wr = wid >> 2, wc = wid & 3, fr = lane & 15, fq = lane >> 4;
    const int K = g.K, nt = K / BK;
    unsigned voffA[2], voffB[2];
#pragma unroll
    for (int i = 0; i < 2; ++i) { int R, C; stage_rc(tid * 16 + i * 8192, R, C); const int Rb = Epi::PERM ? ((R & ~31) + perm32(R & 31)) : R;
        voffA[i] = (unsigned)(R * K + C) * 2u; voffB[i] = (unsigned)(Rb * K + C) * 2u; }
    const size_t kstep = (size_t)(BK * 2);
    const size_t hstep = (size_t)HALF * K * 2;
    const size_t tstep = 2 * hstep;
    const unsigned ldsw = (unsigned)wid * 1024u;
    const int aoff = lds_byte(wr * 64 + fr, fq * 8), boff = lds_byte(wc * 32 + fr, fq * 8);
#define PG8_SA(b, h) (((b) * 2 + (h)) * HTB)
#define PG8_SB(b, h) ((4 + (b) * 2 + (h)) * HTB)
#define PG8_STAGE(bufoff, gbase, voff) do { _Pragma("unroll") for (int _i = 0; _i < 2; ++_i) \
        __builtin_amdgcn_global_load_lds((const unsigned*)((const char*)(gbase) + (voff)[_i]), (PG8_LAS unsigned*)(lds + (bufoff) + ldsw + _i * 8192), 16, 0, 0); } while (0)
#define PG8_LDA(dst, b, h) do { _Pragma("unroll") for (int m = 0; m < 4; ++m) _Pragma("unroll") for (int k = 0; k < 2; ++k) dst[m][k] = *(const PG8_LAS bf16x8*)(lds + PG8_SA(b, h) + aoff + m * 2048 + k * 1024); } while (0)
#define PG8_LDB(dst, b, h) do { _Pragma("unroll") for (int n = 0; n < 2; ++n) _Pragma("unroll") for (int k = 0; k < 2; ++k) dst[n][k] = *(const PG8_LAS bf16x8*)(lds + PG8_SB(b, h) + boff + n * 2048 + k * 1024); } while (0)
#define PG8_MMA(ai, bj, At, Bt) do { __builtin_amdgcn_s_setprio(1); _Pragma("unroll") for (int m = 0; m < 4; ++m) _Pragma("unroll") for (int n = 0; n < 2; ++n) _Pragma("unroll") for (int k = 0; k < 2; ++k) \
        acc[ai][bj][m][n] = __builtin_amdgcn_mfma_f32_16x16x32_bf16(Bt[n][k], At[m][k], acc[ai][bj][m][n], 0, 0, 0); __builtin_amdgcn_s_setprio(0); } while (0)
#define PG8_WAIT_V(n) asm volatile("s_waitcnt vmcnt(" #n ")" ::: "memory")
#define PG8_WAIT_L(n) asm volatile("s_waitcnt lgkmcnt(" #n ")" ::: "memory")
#define PG8_BAR __builtin_amdgcn_s_barrier()
#define PG8_SCHED __builtin_amdgcn_sched_barrier(0)
    Unit cur, nxt; int ui = 0;
    if (!S.next(0, cur)) return;
    f32x4 acc[2][2][4][2];
#pragma unroll
    for (int a = 0; a < 2; ++a)
#pragma unroll
        for (int b = 0; b < 2; ++b)
#pragma unroll
            for (int m = 0; m < 4; ++m)
#pragma unroll
                for (int n = 0; n < 2; ++n) acc[a][b][m][n] = (f32x4){0.f, 0.f, 0.f, 0.f};
    bf16x8 At[4][2], B0[2][2], B1[2][2];
    const char* cA = (const char*)g.A + (size_t)cur.pm * tstep; const char* cB = (const char*)g.Bt + (size_t)cur.pn * tstep;
    S.a_ready(cur);
    if constexpr (SP2) {
        PG8_STAGE(PG8_SB(0, 0), cB, voffB); PG8_STAGE(PG8_SB(0, 1), cB + hstep, voffB); PG8_STAGE(PG8_SA(0, 0), cA, voffA); PG8_STAGE(PG8_SA(0, 1), cA + hstep, voffA);
        if (wr == 1) PG8_BAR;
        PG8_WAIT_V(2); PG8_BAR;
        PG8_STAGE(PG8_SB(1, 0), cB + kstep, voffB); PG8_STAGE(PG8_SA(1, 0), cA + kstep, voffA); PG8_STAGE(PG8_SB(1, 1), cB + hstep + kstep, voffB);
        PG8_WAIT_V(6); PG8_BAR;
    } else {
        PG8_STAGE(PG8_SB(0, 0), cB, voffB); PG8_STAGE(PG8_SA(0, 0), cA, voffA); PG8_STAGE(PG8_SB(0, 1), cB + hstep, voffB); PG8_STAGE(PG8_SA(0, 1), cA + hstep, voffA);
        if (wr == 1) PG8_BAR;
        PG8_WAIT_V(4); PG8_BAR;
        PG8_STAGE(PG8_SB(1, 0), cB + kstep, voffB); PG8_STAGE(PG8_SA(1, 0), cA + kstep, voffA); PG8_STAGE(PG8_SB(1, 1), cB + hstep + kstep, voffB);
        PG8_WAIT_V(6); PG8_BAR;
    }
    for (;;) {
        const bool has_next = S.next(ui + 1, nxt);
        const char* nA = has_next ? (const char*)g.A + (size_t)nxt.pm * tstep : cA; const char* nB = has_next ? (const char*)g.Bt + (size_t)nxt.pn * tstep : cB;
        for (int t = 0; t < nt; t += 2) {
            const bool last = (t == nt - 2);
            const char* a1 = cA + (size_t)(t + 1) * kstep;
            const char* a2 = last ? nA : cA + (size_t)(t + 2) * kstep; const char* b2 = last ? nB : cB + (size_t)(t + 2) * kstep;
            const char* a3 = a2 + kstep; const char* b3 = b2 + kstep;
            if (last && has_next) S.a_ready(nxt);
            if constexpr (SP2) {
            PG8_LDB(B0, 0, 0); PG8_LDB(B1, 0, 1); PG8_SCHED; PG8_LDA(At, 0, 0); PG8_STAGE(PG8_SA(1, 1), a1 + hstep, voffA);
            PG8_WAIT_V(8); PG8_WAIT_L(0); PG8_BAR; PG8_MMA(0, 0, At, B0); PG8_MMA(0, 1, At, B1); PG8_BAR; PG8_SCHED;
            PG8_LDA(At, 0, 1); PG8_STAGE(PG8_SB(0, 0), b2, voffB); PG8_STAGE(PG8_SB(0, 1), b2 + hstep, voffB); PG8_STAGE(PG8_SA(0, 0), a2, voffA);
            PG8_WAIT_V(8); PG8_WAIT_L(0); PG8_BAR; PG8_MMA(1, 0, At, B0); PG8_MMA(1, 1, At, B1); PG8_BAR; PG8_SCHED;
            PG8_LDB(B0, 1, 0); PG8_LDB(B1, 1, 1); PG8_SCHED; PG8_LDA(At, 1, 0); PG8_STAGE(PG8_SA(0, 1), a2 + hstep, voffA);
            PG8_WAIT_V(8); PG8_WAIT_L(0); PG8_BAR; PG8_MMA(0, 0, At, B0); PG8_MMA(0, 1, At, B1); PG8_BAR; PG8_SCHED;
            PG8_LDA(At, 1, 1); PG8_STAGE(PG8_SB(1, 0), b3, voffB); PG8_STAGE(PG8_SB(1, 1), b3 + hstep, voffB); PG8_STAGE(PG8_SA(1, 0), a3, voffA);
            PG8_WAIT_V(8); PG8_WAIT_L(0); PG8_BAR; PG8_MMA(1, 0, At, B0); PG8_MMA(1, 1, At, B1); PG8_BAR; PG8_SCHED;
            } else {
            PG8_LDB(B0, 0, 0); PG8_SCHED; PG8_LDA(At, 0, 0); PG8_STAGE(PG8_SA(1, 1), a1 + hstep, voffA);
            PG8_WAIT_L(8); PG8_BAR; PG8_WAIT_L(0); PG8_MMA(0, 0, At, B0); PG8_BAR; PG8_SCHED;
            PG8_LDB(B1, 0, 1); PG8_STAGE(PG8_SB(0, 0), b2, voffB);
            PG8_BAR; PG8_WAIT_L(0); PG8_MMA(0, 1, At, B1); PG8_BAR;
            PG8_LDA(At, 0, 1); PG8_STAGE(PG8_SA(0, 0), a2, voffA);
            PG8_BAR; PG8_WAIT_L(0); PG8_MMA(1, 0, At, B0); PG8_BAR; PG8_SCHED;
            PG8_STAGE(PG8_SB(0, 1), b2 + hstep, voffB);
            PG8_WAIT_V(6); PG8_BAR; PG8_MMA(1, 1, At, B1); PG8_BAR;
            PG8_LDB(B0, 1, 0); PG8_SCHED; PG8_LDA(At, 1, 0); PG8_STAGE(PG8_SA(0, 1), a2 + hstep, voffA);
            PG8_WAIT_L(8); PG8_BAR; PG8_WAIT_L(0); PG8_MMA(0, 0, At, B0); PG8_BAR; PG8_SCHED;
            PG8_LDB(B1, 1, 1); PG8_STAGE(PG8_SB(1, 0), b3, voffB);
            PG8_BAR; PG8_WAIT_L(0); PG8_MMA(0, 1, At, B1); PG8_BAR;
            PG8_LDA(At, 1, 1); PG8_STAGE(PG8_SA(1, 0), a3, voffA);
            PG8_BAR; PG8_WAIT_L(0); PG8_MMA(1, 0, At, B0); PG8_BAR; PG8_SCHED;
            PG8_STAGE(PG8_SB(1, 1), b3 + hstep, voffB);
            PG8_WAIT_V(6); PG8_BAR; PG8_MMA(1, 1, At, B1); PG8_BAR;
            }
        }
        if constexpr (ALIGN_EPI) { if (wr == 0) PG8_BAR; }
        if constexpr (!Epi::AFTER_DRAIN) { E(acc, cur, wr, wc, fr, fq); S.done(cur); }
        if (!has_next) break;
#pragma unroll
        for (int a = 0; a < 2; ++a)
#pragma unroll
            for (int b = 0; b < 2; ++b)
#pragma unroll
                for (int m = 0; m < 4; ++m)
#pragma unroll
                    for (int n = 0; n < 2; ++n) acc[a][b][m][n] = (f32x4){0.f, 0.f, 0.f, 0.f};
        cur = nxt; cA = nA; cB = nB; ++ui;
        if constexpr (ALIGN_EPI) { if (wr == 1) PG8_BAR; }
    }
    PG8_WAIT_V(0);
    if constexpr (!ALIGN_EPI) { if (wr == 0) PG8_BAR; }
    PG8_BAR;
    if constexpr (Epi::AFTER_DRAIN) { E.fused(acc, cur, wr, wc, fr, fq, lds, wid, lane); S.done(cur); }
#undef PG8_SA
#undef PG8_SB
#undef PG8_STAGE
#undef PG8_LDA
#undef PG8_LDB
#undef PG8_MMA
#undef PG8_WAIT_V
#undef PG8_WAIT_L
#undef PG8_BAR
#undef PG8_SCHED
}
}

#include <hip/hip_cooperative_groups.h>
namespace cg = cooperative_groups;

#define DEV __device__ __forceinline__
#define LAS __attribute__((address_space(3)))
typedef LAS unsigned char* lptr;
typedef unsigned short bf16_t;
typedef short bf16x8 __attribute__((ext_vector_type(8)));
typedef float f32x4 __attribute__((ext_vector_type(4)));
typedef unsigned u32x4 __attribute__((ext_vector_type(4)));
typedef unsigned u32x2 __attribute__((ext_vector_type(2)));
typedef short v4i16_t __attribute__((ext_vector_type(4)));

constexpr int NB = 32, SEQ = 2048, DM = 1024, MTOK = NB * SEQ;
constexpr int NPROJ = 3072, DFF = 2816, PLE = 256;
constexpr int NLAYER = 2;
constexpr float EPSN = 1e-6f;
constexpr int C_Z = 0, C_X = 384, C_B = 768, C_C = 1024, C_LX = 1280, C_LG = 1536, C_Q = 1792, C_K = 2176, C_V = 2560, C_DT = 2944;

constexpr size_t MiB = 1u << 20;
constexpr size_t WS_CTL = 0;
constexpr size_t WS_RS = 1 * MiB;
constexpr size_t WS_SIDE = 5 * MiB;
constexpr size_t WS_WIN = 9 * MiB;
constexpr size_t WS_WOUT = 21 * MiB;
constexpr size_t WS_WGU = 25 * MiB;
constexpr size_t WS_WDN = 47 * MiB;
constexpr size_t WS_WPG = 58 * MiB;
constexpr size_t WS_WPP = 62 * MiB;
constexpr size_t WS_HBA = 64 * MiB;
constexpr size_t WS_Y = 192 * MiB;
constexpr size_t WS_PP = 320 * MiB;
constexpr size_t WS_PB = 448 * MiB;
constexpr size_t WS_PROJ = 512 * MiB;
constexpr size_t WS_END = 896 * MiB;
enum { RS_IN0 = 0, RS_IN1 = 1, RS_FINAL = 2, RS_N2 = 3  , RS_N3 = 5, RS_SSD = 7, RS_LRU = 9, RS_FOX = 11, RS_COUNT = 13 };

constexpr int LDS_BYTES = 163840;

struct Args { const float* in[30]; float* out; unsigned char* ws; int ph_lo, ph_hi; };

DEV unsigned pk2(float lo, float hi) { unsigned r; asm("v_cvt_pk_bf16_f32 %0, %1, %2" : "=v"(r) : "v"(lo), "v"(hi)); return r; }
DEV unsigned f2bf(float f) { return pk2(f, 0.f) & 0xffffu; }
DEV float bf2f(unsigned v) { return __builtin_bit_cast(float, v << 16); }
DEV float bflo(unsigned w) { return __builtin_bit_cast(float, w << 16); }
DEV float bfhi(unsigned w) { return __builtin_bit_cast(float, w & 0xffff0000u); }
DEV float ex2_(float x) { return __builtin_amdgcn_exp2f(x); }
DEV float sigmoidf_(float x) { return __builtin_amdgcn_rcpf(1.f + ex2_(-1.4426950408889634f * x)); }
DEV float siluf_(float x) { return x * sigmoidf_(x); }
DEV float softplusf_(float x) { return fmaxf(x, 0.f) + log1pf(__expf(-fabsf(x))); }
DEV float gelu_tanhf_(float x) { const float u = 0.7978845608028654f * (x + 0.044715f * x * x * x); return x * sigmoidf_(2.f * u); }
DEV void unpack8(const u32x4 r, float (&v)[8]) { v[0] = bflo(r.x); v[1] = bfhi(r.x); v[2] = bflo(r.y); v[3] = bfhi(r.y); v[4] = bflo(r.z); v[5] = bfhi(r.z); v[6] = bflo(r.w); v[7] = bfhi(r.w); }
DEV bf16x8 ldsA(lptr p) { return *(const LAS bf16x8*)p; }
DEV float wave_sum64(float v) {
#pragma unroll
    for (int o = 1; o < 64; o <<= 1) v += __shfl_xor(v, o);
    return v;
}
#define MFMA16(a, b, c) __builtin_amdgcn_mfma_f32_16x16x32_bf16((a), (b), (c), 0, 0, 0)
#define WGBAR() asm volatile("s_waitcnt lgkmcnt(0)\n\ts_barrier" ::: "memory")

using pg8::Unit; using pg8::BM; using pg8::HALF; using pg8::cvt_pk_bf16;

struct EpiProj {
    static constexpr bool PERM = true, AFTER_DRAIN = false;
    bf16_t* O; const float* rowss; float* side;
    __device__ __forceinline__ void operator()(const f32x4 (&acc)[2][2][4][2], const Unit& u, int wr, int wc, int fr, int fq) const {
        const int row0 = u.pm * BM + wr * 64 + fr, col0 = u.pn * BM + wc * 32 + 8 * fq;
        const bool sidew = (u.pn == 11) && (wc == 0) && (fq < 2);
        float rsv[2][4];
#pragma unroll
        for (int ai = 0; ai < 2; ++ai)
#pragma unroll
            for (int m = 0; m < 4; ++m) rsv[ai][m] = rowss[row0 + ai * HALF + m * 16];
#pragma unroll
        for (int ai = 0; ai < 2; ++ai)
#pragma unroll
            for (int m = 0; m < 4; ++m) {
                const int row = row0 + ai * HALF + m * 16; const float rs = rsqrtf(rsv[ai][m] * (1.f / 1024.f) + EPSN);
                bf16_t* rowp = O + (size_t)row * NPROJ + col0;
#pragma unroll
                for (int bj = 0; bj < 2; ++bj) { const f32x4 v0 = acc[ai][bj][m][0] * rs, v1 = acc[ai][bj][m][1] * rs;
                    u32x4 w; w.x = cvt_pk_bf16(v0[0], v0[1]); w.y = cvt_pk_bf16(v0[2], v0[3]); w.z = cvt_pk_bf16(v1[0], v1[1]); w.w = cvt_pk_bf16(v1[2], v1[3]);
                    *(u32x4*)(rowp + bj * HALF) = w;
                    if (bj == 1 && sidew) { *(f32x4*)(side + (size_t)row * 16 + 8 * fq) = v0; if (fq == 0) *(f32x4*)(side + (size_t)row * 16 + 4) = v1; } }
            }
    }
};
struct EpiResid {
    static constexpr bool PERM = true, AFTER_DRAIN = false;
    const bf16_t* hin; bf16_t* hout; float* rowss_out;
    __device__ __forceinline__ void operator()(const f32x4 (&acc)[2][2][4][2], const Unit& u, int wr, int wc, int fr, int fq) const {
        const int row0 = u.pm * BM + wr * 64 + fr, col0 = u.pn * BM + wc * 32 + 8 * fq;
#pragma unroll
        for (int ai = 0; ai < 2; ++ai) {
            u32x4 hr[4][2];
#pragma unroll
            for (int m = 0; m < 4; ++m)
#pragma unroll
                for (int bj = 0; bj < 2; ++bj) hr[m][bj] = *(const u32x4*)(hin + (size_t)(row0 + ai * HALF + m * 16) * DM + col0 + bj * HALF);
#pragma unroll
            for (int m = 0; m < 4; ++m) {
                const int row = row0 + ai * HALF + m * 16; float ss = 0.f;
#pragma unroll
                for (int bj = 0; bj < 2; ++bj) { const size_t off = (size_t)row * DM + col0 + bj * HALF;
                    float hv[8]; unpack8(hr[m][bj], hv);
#pragma unroll
                    for (int j = 0; j < 4; ++j) { hv[j] += acc[ai][bj][m][0][j]; hv[4 + j] += acc[ai][bj][m][1][j]; }
                    u32x4 w; w.x = cvt_pk_bf16(hv[0], hv[1]); w.y = cvt_pk_bf16(hv[2], hv[3]); w.z = cvt_pk_bf16(hv[4], hv[5]); w.w = cvt_pk_bf16(hv[6], hv[7]);
                    *(u32x4*)(hout + off) = w;
#pragma unroll
                    for (int j = 0; j < 8; ++j) ss += hv[j] * hv[j]; }
                ss += __shfl_xor(ss, 16); ss += __shfl_xor(ss, 32);
                if (fq == 0) unsafeAtomicAdd(rowss_out + row, ss);
            }
        }
    }
};
struct EpiSwiGLU {
    static constexpr bool PERM = true, AFTER_DRAIN = false;
    bf16_t* O; const float* rowss;
    __device__ __forceinline__ void operator()(const f32x4 (&acc)[2][2][4][2], const Unit& u, int wr, int wc, int fr, int fq) const {
        const int row0 = u.pm * BM + wr * 64 + fr, col0 = u.pn * HALF + wc * 32 + 8 * fq;
        float rsv[2][4];
#pragma unroll
        for (int ai = 0; ai < 2; ++ai)
#pragma unroll
            for (int m = 0; m < 4; ++m) rsv[ai][m] = rowss[row0 + ai * HALF + m * 16];
#pragma unroll
        for (int ai = 0; ai < 2; ++ai)
#pragma unroll
            for (int m = 0; m < 4; ++m) {
                const int row = row0 + ai * HALF + m * 16; const float rs = rsqrtf(rsv[ai][m] * (1.f / 1024.f) + EPSN);
                float o[8];
#pragma unroll
                for (int n = 0; n < 2; ++n)
#pragma unroll
                    for (int j = 0; j < 4; ++j) { const float g = acc[ai][0][m][n][j] * rs, uu = acc[ai][1][m][n][j] * rs; o[4 * n + j] = siluf_(g) * uu; }
                u32x4 w; w.x = cvt_pk_bf16(o[0], o[1]); w.y = cvt_pk_bf16(o[2], o[3]); w.z = cvt_pk_bf16(o[4], o[5]); w.w = cvt_pk_bf16(o[6], o[7]);
                *(u32x4*)(O + (size_t)row * DFF + col0) = w;
            }
    }
};
struct EpiPP {
    static constexpr bool PERM = true, AFTER_DRAIN = false;
    bf16_t* O;
    __device__ __forceinline__ void operator()(const f32x4 (&acc)[2][2][4][2], const Unit& u, int wr, int wc, int fr, int fq) const {
        const int row0 = u.pm * BM + wr * 64 + fr, col0 = u.pn * BM + wc * 32 + 8 * fq;
#pragma unroll
        for (int ai = 0; ai < 2; ++ai)
#pragma unroll
            for (int m = 0; m < 4; ++m) { bf16_t* rowp = O + (size_t)(row0 + ai * HALF + m * 16) * DM + col0;
#pragma unroll
                for (int bj = 0; bj < 2; ++bj) { const f32x4 v0 = acc[ai][bj][m][0], v1 = acc[ai][bj][m][1];
                    u32x4 w; w.x = cvt_pk_bf16(v0[0], v0[1]); w.y = cvt_pk_bf16(v0[2], v0[3]); w.z = cvt_pk_bf16(v1[0], v1[1]); w.w = cvt_pk_bf16(v1[2], v1[3]);
                    *(u32x4*)(rowp + bj * HALF) = w; } }
    }
};
struct EpiPle {
    static constexpr bool PERM = true, AFTER_DRAIN = false;
    const bf16_t* hin; bf16_t* hout; const bf16_t* pp; const float* bias; const float* rowss; float* rowss_out;
    __device__ __forceinline__ void operator()(const f32x4 (&acc)[2][2][4][2], const Unit& u, int wr, int wc, int fr, int fq) const {
        const int row0 = u.pm * BM + wr * 64 + fr, col0 = u.pn * BM + wc * 32 + 8 * fq;
        f32x4 bv[2][2];
#pragma unroll
        for (int bj = 0; bj < 2; ++bj) { bv[bj][0] = *(const f32x4*)(bias + col0 + bj * HALF); bv[bj][1] = *(const f32x4*)(bias + col0 + bj * HALF + 4); }
        float rsv[2][4];
#pragma unroll
        for (int ai = 0; ai < 2; ++ai)
#pragma unroll
            for (int m = 0; m < 4; ++m) rsv[ai][m] = rowss[row0 + ai * HALF + m * 16];
#pragma unroll
        for (int ai = 0; ai < 2; ++ai)
#pragma unroll
            for (int mp = 0; mp < 2; ++mp) {
                u32x4 hr[2][2], pr[2][2];
#pragma unroll
                for (int mm = 0; mm < 2; ++mm)
#pragma unroll
                    for (int bj = 0; bj < 2; ++bj) { const size_t off = (size_t)(row0 + ai * HALF + (2 * mp + mm) * 16) * DM + col0 + bj * HALF; hr[mm][bj] = *(const u32x4*)(hin + off); pr[mm][bj] = *(const u32x4*)(pp + off); }
#pragma unroll
                for (int mm = 0; mm < 2; ++mm) { const int m = 2 * mp + mm;
                    const int row = row0 + ai * HALF + m * 16; const float rs = rsqrtf(rsv[ai][m] * (1.f / 1024.f) + EPSN); float ss = 0.f;
#pragma unroll
                    for (int bj = 0; bj < 2; ++bj) { const size_t off = (size_t)row * DM + col0 + bj * HALF;
                        float hv[8], pv[8]; unpack8(hr[mm][bj], hv); unpack8(pr[mm][bj], pv);
#pragma unroll
                        for (int j = 0; j < 4; ++j) { hv[j] += sigmoidf_(acc[ai][bj][m][0][j] * rs + bv[bj][0][j]) * pv[j]; hv[4 + j] += sigmoidf_(acc[ai][bj][m][1][j] * rs + bv[bj][1][j]) * pv[4 + j]; }
                        u32x4 w; w.x = cvt_pk_bf16(hv[0], hv[1]); w.y = cvt_pk_bf16(hv[2], hv[3]); w.z = cvt_pk_bf16(hv[4], hv[5]); w.w = cvt_pk_bf16(hv[6], hv[7]);
                        *(u32x4*)(hout + off) = w;
#pragma unroll
                        for (int j = 0; j < 8; ++j) ss += hv[j] * hv[j]; }
                    ss += __shfl_xor(ss, 16); ss += __shfl_xor(ss, 32);
                    if (fq == 0) unsafeAtomicAdd(rowss_out + row, ss);
                }
            }
    }
};

struct InTab {
    const __attribute__((address_space(4))) char* kp;
    DEV const float* operator[](int i) const { return (const float*)(*(const __attribute__((address_space(1))) float* const __attribute__((address_space(4)))*)(kp + 8 * i)); }
};
struct Ctx {
    InTab in; float* out; unsigned char* ws;
    lptr L; int tid, lane, wave, G, bid;
    DEV float* rs(int i) const { return (float*)(ws + WS_RS) + (size_t)i * MTOK; }
    DEV bf16_t* bfp(size_t off) const { return (bf16_t*)(ws + off); }
};

DEV void p0_item(const Ctx& c, const float* W0, const float* W1, int K, int N, int mode, const float* gain, const float* g1, const float* g2, bf16_t* dst, int item, int nblk) {
    LAS float* scr = (LAS float*)(c.L + c.wave * 16384);
    const int lane = c.lane, kb = item / nblk, nb = item % nblk, k0 = 64 * kb, n0 = 32 * nb;
    const int r = n0 + (lane & 31); int sc = r; const float* W = W0;
    if (mode == 1) { if (r < 1280) sc = r; else if (r < 2944) sc = r + 6; else if (r < 2950) sc = 1280 + (r - 2944); else if (r < 2956) sc = r; else sc = -1; }
    else if (mode == 2) { const int t = r >> 8, w = r & 255; sc = 128 * t + (w & 127); W = (w < 128) ? W0 : W1; }
    const int scc = sc < 0 ? 0 : sc; const float keep = sc < 0 ? 0.f : 1.f;
    float wv[32], gv[32];
#pragma unroll
    for (int i = 0; i < 32; ++i) { const int k = k0 + 2 * i + (lane >> 5); wv[i] = W[(size_t)k * N + scc];
        if (gain) { const float* gp = g1 ? ((k < 384) ? gain + k : (k < 640 ? g1 + (k - 384) : g2 + (k - 640))) : gain + k; gv[i] = *gp; } else gv[i] = 1.f; }
#pragma unroll
    for (int i = 0; i < 32; ++i) scr[(2 * i + (lane >> 5)) * 33 + (lane & 31)] = wv[i] * gv[i] * keep;
    asm volatile("s_waitcnt lgkmcnt(0)" ::: "memory");
    const int cc = lane & 7;
#pragma unroll
    for (int j = 0; j < 4; ++j) { const int n = (lane >> 3) + 8 * j; const LAS float* s = scr + (8 * cc) * 33 + n;
        u32x4 o; o.x = pk2(s[0 * 33], s[1 * 33]); o.y = pk2(s[2 * 33], s[3 * 33]); o.z = pk2(s[4 * 33], s[5 * 33]); o.w = pk2(s[6 * 33], s[7 * 33]);
        *(u32x4*)(dst + (size_t)(n0 + n) * K + k0 + 8 * cc) = o; }
    asm volatile("s_waitcnt lgkmcnt(0)" ::: "memory");
}
constexpr int P0_I_IN = 16 * 96, P0_I_OUT = 16 * 32, P0_I_GU = 16 * 176, P0_I_DN = 44 * 32, P0_I_PG = 16 * 32, P0_I_PP = 4 * 32, P0_I_L = P0_I_IN + P0_I_OUT + P0_I_GU + P0_I_DN + P0_I_PG + P0_I_PP;
DEV void p0_weight_item(const Ctx& c, int l, int r) {
    if (r < P0_I_IN) { p0_item(c, c.in[3] + (size_t)l * 1024 * 2956, nullptr, 1024, 2956, 1, c.in[2] + l * 1024, nullptr, nullptr, c.bfp(WS_WIN) + (size_t)l * NPROJ * 1024, r, 96); return; } r -= P0_I_IN;
    if (r < P0_I_OUT) { p0_item(c, c.in[20] + (size_t)l * 1024 * 1024, nullptr, 1024, 1024, 0, c.in[9] + l * 384, c.in[17] + l * 256, c.in[19] + l * 384, c.bfp(WS_WOUT) + (size_t)l * 1024 * 1024, r, 32); return; } r -= P0_I_OUT;
    if (r < P0_I_GU) { p0_item(c, c.in[22] + (size_t)l * 1024 * DFF, c.in[23] + (size_t)l * 1024 * DFF, 1024, DFF, 2, c.in[21] + l * 1024, nullptr, nullptr, c.bfp(WS_WGU) + (size_t)l * 5632 * 1024, r, 176); return; } r -= P0_I_GU;
    if (r < P0_I_DN) { p0_item(c, c.in[24] + (size_t)l * DFF * 1024, nullptr, DFF, 1024, 0, nullptr, nullptr, nullptr, c.bfp(WS_WDN) + (size_t)l * 1024 * DFF, r, 32); return; } r -= P0_I_DN;
    if (r < P0_I_PG) { p0_item(c, c.in[26] + (size_t)l * 1024 * 1024, nullptr, 1024, 1024, 0, c.in[25] + l * 1024, nullptr, nullptr, c.bfp(WS_WPG) + (size_t)l * 1024 * 1024, r, 32); return; } r -= P0_I_PG;
    p0_item(c, c.in[28] + (size_t)l * PLE * 1024, nullptr, PLE, 1024, 0, nullptr, nullptr, nullptr, c.bfp(WS_WPP) + (size_t)l * 1024 * PLE, r, 32);
}
DEV void p0_p_items(const Ctx& c, int l, int base) {
    const f32x4* p4 = (const f32x4*)c.in[1] + (size_t)l * (MTOK * PLE / 4); u32x4* o = (u32x4*)c.bfp(WS_PB) + (size_t)l * (MTOK * PLE / 8);
    f32x4 a[8], bq[8];
#pragma unroll
    for (int q = 0; q < 8; ++q) { const size_t i = (size_t)base + q * 512 + c.tid; a[q] = __builtin_nontemporal_load(p4 + 2 * i); bq[q] = __builtin_nontemporal_load(p4 + 2 * i + 1); }
#pragma unroll
    for (int q = 0; q < 8; ++q) { u32x4 w; w.x = pk2(a[q][0], a[q][1]); w.y = pk2(a[q][2], a[q][3]); w.z = pk2(bq[q][0], bq[q][1]); w.w = pk2(bq[q][2], bq[q][3]); o[(size_t)base + q * 512 + c.tid] = w; }
}
DEV void p0_prologue(const Ctx& c) {
    const int gw = c.bid * 8 + c.wave, NGW = c.G * 8;
    const int gt = c.bid * 512 + c.tid, NGT = c.G * 512;
    { f32x4* z = (f32x4*)c.rs(1); const int n4 = (RS_COUNT - 1) * MTOK / 4; for (int i = gt; i < n4; i += NGT) z[i] = (f32x4){0.f, 0.f, 0.f, 0.f};
      unsigned* ctl = (unsigned*)(c.ws + WS_CTL); if (gt < 4096) ctl[gt] = 0u; }
    for (int it = gw; it < P0_I_L; it += NGW) p0_weight_item(c, 0, it);
    { float* rs0 = c.rs(RS_IN0); bf16_t* hb = c.bfp(WS_HBA);
      for (int m0 = gw; m0 < MTOK; m0 += 8 * NGW) {
          f32x4 v[8][4];
#pragma unroll
          for (int q = 0; q < 8; ++q) { const f32x4* xr = (const f32x4*)(c.in[0] + (size_t)(m0 + q * NGW) * DM) + c.lane;
#pragma unroll
              for (int j = 0; j < 4; ++j) v[q][j] = __builtin_nontemporal_load(xr + 64 * j); }
#pragma unroll
          for (int q = 0; q < 8; ++q) { const int m = m0 + q * NGW; float s = 0.f; u32x2* o = (u32x2*)(hb + (size_t)m * DM) + c.lane;
#pragma unroll
              for (int j = 0; j < 4; ++j) { const f32x4 t = v[q][j]; s += (t[0] * t[0] + t[1] * t[1]) + (t[2] * t[2] + t[3] * t[3]); u32x2 w; w.x = pk2(t[0], t[1]); w.y = pk2(t[2], t[3]); o[64 * j] = w; }
              s = wave_sum64(s); if (c.lane == 0) rs0[m] = s; } } }
    for (int base = c.bid * 4096; base < MTOK * PLE / 8; base += c.G * 4096) p0_p_items(c, 0, base);
}

DEV bf16x8 vtr8(lptr p0, lptr p1) {
    const v4i16_t lo = __builtin_amdgcn_ds_read_tr16_b64_v4i16((LAS v4i16_t*)p0), hi = __builtin_amdgcn_ds_read_tr16_b64_v4i16((LAS v4i16_t*)p1);
    return (bf16x8){lo[0], lo[1], lo[2], lo[3], hi[0], hi[1], hi[2], hi[3]};
}
DEV bf16x8 trfrag(lptr img, int pitch, int k0, int c0, int r16, int g4) { const lptr p = img + (k0 + 8 * g4 + (r16 >> 2)) * pitch + (c0 + 4 * (r16 & 3)) * 2; return vtr8(p, p + 4 * pitch); }
constexpr int SP = 272, XP = 144;
constexpr int O_XS = 0, O_BM = O_XS + 128 * XP, O_BW = O_BM + 128 * SP, O_CM = O_BW + 128 * SP, O_PREV = O_CM + 128 * SP, O_FL = O_PREV + 64 * SP, O_DUMMY = O_FL + 2048, O_SEQ = O_DUMMY + 4096;
static_assert(O_SEQ + 16384 <= LDS_BYTES - 64, "ssd lds");
DEV void ssd_unit(const Ctx& c, int layer, int b, int h) {
    const lptr L = c.L; const int tid = c.tid, lane = c.lane, w = c.wave, r16 = lane & 15, g4 = lane >> 4;
    const int grp = h / 3;
    const bf16_t* proj = c.bfp(WS_PROJ); const float* side = (const float*)(c.ws + WS_SIDE); bf16_t* ybuf = c.bfp(WS_Y);
    float* rss = c.rs(RS_SSD + layer);
    const float* cw = c.in[4] + (size_t)layer * 4 * 896; const float* cb = c.in[5] + (size_t)layer * 896;
    const float Aneg = -__expf(c.in[7][layer * 6 + h]), dtb = c.in[6][layer * 6 + h], Dh = c.in[8][layer * 6 + h];
    LAS float* dt_all = (LAS float*)(L + O_SEQ); LAS float* acs_all = dt_all + SEQ;
    f32x4 S[4];
#pragma unroll
    for (int i = 0; i < 4; ++i) S[i] = (f32x4){0.f, 0.f, 0.f, 0.f};
    const int cg4 = tid % 80, t0 = (tid / 80) * 22; const bool conv_on = tid < 480;
    const int cc = cg4 * 4;
    const int col = (cc < 64) ? (C_X + h * 64 + cc) : (cc < 192 ? (C_B + grp * 128 + (cc - 64)) : (C_C + grp * 128 + (cc - 192)));
    const int cidx = (cc < 64) ? (h * 64 + cc) : (cc < 192 ? (384 + grp * 128 + (cc - 64)) : (640 + grp * 128 + (cc - 192)));
    const f32x4 wt0 = *(const f32x4*)(cw + cidx), wt1 = *(const f32x4*)(cw + 896 + cidx), wt2 = *(const f32x4*)(cw + 2 * 896 + cidx), wt3 = *(const f32x4*)(cw + 3 * 896 + cidx), wbs = *(const f32x4*)(cb + cidx);
    const bool isB = (cc >= 64) && (cc < 192);
    const int dst0 = (cc < 64) ? (O_XS + cc * 2) : (cc < 192 ? (O_BM + (cc - 64) * 2) : (O_CM + (cc - 192) * 2)), pitch0 = (cc < 64) ? XP : SP;
    const int dst1 = O_BW + (cc - 64) * 2, dummy = O_DUMMY + tid * 8;
    { float d[4], run = 0.f, pre[4];
#pragma unroll
      for (int i = 0; i < 4; ++i) d[i] = side[(size_t)(b * SEQ + 4 * tid + i) * 16 + h];
#pragma unroll
      for (int i = 0; i < 4; ++i) { d[i] = softplusf_(d[i] + dtb); run += Aneg * d[i]; pre[i] = run; }
      float sc = run;
#pragma unroll
      for (int o = 1; o < 32; o <<= 1) { const float t = __shfl_up(sc, o, 32); if ((lane & 31) >= o) sc += t; }
      const float base = sc - run;
      *(LAS f32x4*)(dt_all + 4 * tid) = (f32x4){d[0], d[1], d[2], d[3]}; *(LAS f32x4*)(acs_all + 4 * tid) = (f32x4){base + pre[0], base + pre[1], base + pre[2], base + pre[3]}; }
    WGBAR();
    for (int ch = 0; ch < 16; ++ch) {
        const int row0 = b * SEQ + ch * 128;
        const LAS float* dt_s = dt_all + ch * 128; const LAS float* acs_s = acs_all + ch * 128;
#pragma unroll
        for (int i = 0; i < 4; ++i)
#pragma unroll
            for (int r = 0; r < 4; ++r) { const int p = 16 * (w & 3) + 4 * g4 + r, n = 16 * (4 * (w >> 2) + i) + r16; *(LAS unsigned short*)(L + O_PREV + p * SP + n * 2) = (unsigned short)f2bf(S[i][r]); }
        unsigned short zv[4][4];
#pragma unroll
        for (int pt = 0; pt < 4; ++pt)
#pragma unroll
            for (int r = 0; r < 4; ++r) zv[pt][r] = proj[(size_t)(row0 + 16 * w + 4 * g4 + r) * NPROJ + C_Z + h * 64 + 16 * pt + r16];
        WGBAR();
        const float total = acs_s[127];
        if (conv_on) {
            const int sp0 = ch * 128 + t0;
            const bf16_t* src = proj + (size_t)(b * SEQ + sp0) * NPROJ + col;
            const u32x2 zz = (u32x2){0u, 0u};
            const int hb_ = (sp0 >= 3) ? 1 : 0;
            u32x2 r0 = *(const u32x2*)(src - (ptrdiff_t)(3 * hb_) * NPROJ), r1 = *(const u32x2*)(src - (ptrdiff_t)(2 * hb_) * NPROJ), r2 = *(const u32x2*)(src - (ptrdiff_t)hb_ * NPROJ);
            if (!hb_) { r0 = zz; r1 = zz; r2 = zz; }
            f32x4 x0 = (f32x4){bflo(r0.x), bfhi(r0.x), bflo(r0.y), bfhi(r0.y)}, x1 = (f32x4){bflo(r1.x), bfhi(r1.x), bflo(r1.y), bfhi(r1.y)}, x2 = (f32x4){bflo(r2.x), bfhi(r2.x), bflo(r2.y), bfhi(r2.y)};
#pragma unroll 1
            for (int half = 0; half < 2; ++half) {
                u32x2 rr[11];
#pragma unroll
                for (int i = 0; i < 11; ++i) { const int ii = half * 11 + i; const int li = (t0 + ii < 128) ? ii : (127 - t0); rr[i] = *(const u32x2*)(src + (size_t)li * NPROJ); }
                float wlv[11];
#pragma unroll
                for (int i = 0; i < 11; ++i) { const int l_ = t0 + half * 11 + i; const int lw_ = (l_ < 128) ? l_ : 127; wlv[i] = dt_s[lw_] * __expf(total - acs_s[lw_]); }
#pragma unroll
                for (int i = 0; i < 11; ++i) {
                    const int l = t0 + half * 11 + i; const bool valid = l < 128;
                    const u32x2 r3 = rr[i];
                    const f32x4 x3 = (f32x4){bflo(r3.x), bfhi(r3.x), bflo(r3.y), bfhi(r3.y)};
                    const f32x4 a = wbs + wt0 * x0 + wt1 * x1 + wt2 * x2 + wt3 * x3;
                    const f32x4 v = (f32x4){siluf_(a[0]), siluf_(a[1]), siluf_(a[2]), siluf_(a[3])};
                    const float wl = wlv[i];
                    u32x2 o; o.x = pk2(v[0], v[1]); o.y = pk2(v[2], v[3]);
                    u32x2 o2; o2.x = pk2(v[0] * wl, v[1] * wl); o2.y = pk2(v[2] * wl, v[3] * wl);
                    *(LAS u32x2*)(L + (valid ? dst0 + l * pitch0 : dummy)) = o;
                    *(LAS u32x2*)(L + ((valid && isB) ? dst1 + l * SP : dummy)) = o2;
                    x0 = x1; x1 = x2; x2 = x3;
                }
            }
        }
        WGBAR();
        bf16x8 ca[4];
#pragma unroll
        for (int ks = 0; ks < 4; ++ks) ca[ks] = ldsA(L + O_CM + (16 * w + r16) * SP + (32 * ks + 8 * g4) * 2);
        f32x4 Gt[8];
#pragma unroll
        for (int ct = 0; ct < 8; ++ct) { Gt[ct] = (f32x4){0.f, 0.f, 0.f, 0.f};
            if (ct <= w) {
#pragma unroll
                for (int ks = 0; ks < 4; ++ks) Gt[ct] = MFMA16(ca[ks], ldsA(L + O_BM + (16 * ct + r16) * SP + (32 * ks + 8 * g4) * 2), Gt[ct]); } }
        WGBAR();
        { const f32x4 al = *(const LAS f32x4*)(acs_s + 16 * w + 4 * g4);
          float asv[8], dsv[8];
#pragma unroll
          for (int ct = 0; ct < 8; ++ct) { asv[ct] = acs_s[16 * ct + r16]; dsv[ct] = dt_s[16 * ct + r16]; }
#pragma unroll
          for (int ct = 0; ct < 8; ++ct) { const int s = 16 * ct + r16; const float as = asv[ct], ds = dsv[ct];
#pragma unroll
              for (int r = 0; r < 4; ++r) { const int l = 16 * w + 4 * g4 + r; const float v = (s <= l) ? Gt[ct][r] * __expf(al[r] - as) * ds : 0.f;
                  *(LAS unsigned short*)(L + O_BM + l * SP + s * 2) = (unsigned short)f2bf(v); } } }
        WGBAR();
        if (ch < 15 && conv_on) { const bf16_t* nsrc = proj + (size_t)(b * SEQ + (ch + 1) * 128 + t0) * NPROJ + col;
#pragma unroll
            for (int r = -3; r < 22; ++r) { const int li = (t0 + r < 128) ? r : (127 - t0); __builtin_amdgcn_global_load_lds((const unsigned*)(nsrc + (ptrdiff_t)li * NPROJ), (LAS unsigned*)(L + O_DUMMY + w * 256), 4, 0, 0); } }
        f32x4 Y[4];
#pragma unroll
        for (int pt = 0; pt < 4; ++pt) { Y[pt] = (f32x4){0.f, 0.f, 0.f, 0.f};
#pragma unroll
            for (int ks = 0; ks < 4; ++ks) Y[pt] = MFMA16(ca[ks], ldsA(L + O_PREV + (16 * pt + r16) * SP + (32 * ks + 8 * g4) * 2), Y[pt]); }
        { const f32x4 al = *(const LAS f32x4*)(acs_s + 16 * w + 4 * g4);
#pragma unroll
          for (int r = 0; r < 4; ++r) { const float e = __expf(al[r]);
#pragma unroll
              for (int pt = 0; pt < 4; ++pt) Y[pt][r] *= e; } }
#pragma unroll
        for (int ks = 0; ks < 4; ++ks) if (ks <= (w >> 1)) { const bf16x8 sa = ldsA(L + O_BM + (16 * w + r16) * SP + (32 * ks + 8 * g4) * 2);
#pragma unroll
            for (int pt = 0; pt < 4; ++pt) Y[pt] = MFMA16(sa, trfrag(L + O_XS, XP, 32 * ks, 16 * pt, r16, g4), Y[pt]); }
        { float ss[4] = {0.f, 0.f, 0.f, 0.f};
#pragma unroll
          for (int pt = 0; pt < 4; ++pt) { const int p = 16 * pt + r16;
#pragma unroll
              for (int r = 0; r < 4; ++r) { const int l = 16 * w + 4 * g4 + r; const size_t row = (size_t)(row0 + l);
                  const float xs = bf2f(*(const LAS unsigned short*)(L + O_XS + l * XP + p * 2));
                  const float z = bf2f(zv[pt][r]); const float yo = (Y[pt][r] + Dh * xs) * siluf_(z);
                  ybuf[row * DM + h * 64 + p] = (bf16_t)f2bf(yo); ss[r] += yo * yo; } }
#pragma unroll
          for (int r = 0; r < 4; ++r) { float s = ss[r]; s += __shfl_xor(s, 1); s += __shfl_xor(s, 2); s += __shfl_xor(s, 4); s += __shfl_xor(s, 8);
              if (r16 == 0) unsafeAtomicAdd(rss + row0 + 16 * w + 4 * g4 + r, s); } }
        { const float dec = __expf(total);
#pragma unroll
          for (int i = 0; i < 4; ++i) S[i] *= dec;
#pragma unroll
          for (int ks = 0; ks < 4; ++ks) { const bf16x8 xa = trfrag(L + O_XS, XP, 32 * ks, 16 * (w & 3), r16, g4);
#pragma unroll
              for (int i = 0; i < 4; ++i) S[i] = MFMA16(xa, trfrag(L + O_BW, SP, 32 * ks, 16 * (4 * (w >> 2) + i), r16, g4), S[i]); } }
        WGBAR();
    }
}

constexpr int LP = 144;
constexpr int O_LX = 0, O_WA = O_LX + 128 * LP, O_WX = O_WA + 64 * LP, O_XF = O_WX + 64 * LP, O_AS = O_XF + 32768, O_US = O_AS + 32768, O_SEG = O_US + 32768, O_CW = O_SEG + 4096, O_GT = O_CW + 1280;
static_assert(O_GT + 16384 <= LDS_BYTES - 64, "lru lds");
DEV void lru_unit(const Ctx& c, int layer, int b, int g) {
    const lptr L = c.L; const int tid = c.tid, lane = c.lane, w = c.wave, r16 = lane & 15, g4 = lane >> 4;
    const bf16_t* proj = c.bfp(WS_PROJ); bf16_t* ybuf = c.bfp(WS_Y); float* rss = c.rs(RS_LRU + layer);
    const float* cw = c.in[10] + (size_t)layer * 4 * 256; const float* cb = c.in[11] + (size_t)layer * 256;
    const float* wa = c.in[12] + ((size_t)layer * 4 + g) * 4096; const float* wx = c.in[14] + ((size_t)layer * 4 + g) * 4096;
    LAS float* xf = (LAS float*)(L + O_XF); LAS float* a_s = (LAS float*)(L + O_AS); LAS float* u_s = (LAS float*)(L + O_US);
    LAS float* segH = (LAS float*)(L + O_SEG); LAS float* segP = segH + 512;
    for (int e = tid; e < 4096; e += 512) { const int i = e >> 6, j = e & 63;
        *(LAS unsigned short*)(L + O_WA + j * LP + i * 2) = (unsigned short)f2bf(wa[e]); *(LAS unsigned short*)(L + O_WX + j * LP + i * 2) = (unsigned short)f2bf(wx[e]); }
    float ba[4], bx[4], spl[4];
#pragma unroll
    for (int jt = 0; jt < 4; ++jt) { const int ch = 64 * g + 16 * jt + r16; ba[jt] = c.in[13][layer * 256 + ch]; bx[jt] = c.in[15][layer * 256 + ch]; spl[jt] = softplusf_(-c.in[16][layer * 256 + ch]); }
    WGBAR();
    float carry = 0.f;
    const int cgi = tid & 7, t0 = (tid >> 3) * 2;
    LAS float* cwl = (LAS float*)(L + O_CW);
    if (tid < 256) cwl[tid] = cw[(tid >> 6) * 256 + 64 * g + (tid & 63)]; else if (tid < 320) cwl[tid] = cb[64 * g + (tid - 256)];
    u32x4 G0, G1;
    u32x4 R0, R1, R2, R3, R4;
    { const bf16_t* src = proj + (size_t)(b * SEQ + t0) * NPROJ + C_LX + 64 * g + cgi * 8; const u32x4 zz = (u32x4){0u, 0u, 0u, 0u};
      R0 = t0 >= 3 ? *(const u32x4*)(src - 3 * NPROJ) : zz; R1 = t0 >= 2 ? *(const u32x4*)(src - 2 * NPROJ) : zz; R2 = t0 >= 1 ? *(const u32x4*)(src - 1 * NPROJ) : zz; R3 = *(const u32x4*)(src); R4 = *(const u32x4*)(src + NPROJ);
      G0 = *(const u32x4*)(src + (C_LG - C_LX)); G1 = *(const u32x4*)(src + NPROJ + (C_LG - C_LX)); }
    for (int ch = 0; ch < 16; ++ch) {
        const int row0 = b * SEQ + ch * 128;
        { float x0[8], x1[8], x2[8], x3[8], x4[8];
          unpack8(R0, x0); unpack8(R1, x1); unpack8(R2, x2); unpack8(R3, x3); unpack8(R4, x4);
          *(LAS u32x4*)(L + O_GT + t0 * 128 + cgi * 16) = G0; *(LAS u32x4*)(L + O_GT + (t0 + 1) * 128 + cgi * 16) = G1;
          if (ch < 15) { const bf16_t* src = proj + (size_t)(row0 + 128 + t0) * NPROJ + C_LX + 64 * g + cgi * 8;
              R0 = *(const u32x4*)(src - 3 * NPROJ); R1 = *(const u32x4*)(src - 2 * NPROJ); R2 = *(const u32x4*)(src - 1 * NPROJ); R3 = *(const u32x4*)(src); R4 = *(const u32x4*)(src + NPROJ);
              G0 = *(const u32x4*)(src + (C_LG - C_LX)); G1 = *(const u32x4*)(src + NPROJ + (C_LG - C_LX)); }
          float v0[8], v1[8];
#pragma unroll
          for (int j = 0; j < 8; ++j) { const float bsj = cwl[256 + cgi * 8 + j], w0 = cwl[cgi * 8 + j], w1 = cwl[64 + cgi * 8 + j], w2 = cwl[128 + cgi * 8 + j], w3 = cwl[192 + cgi * 8 + j];
              v0[j] = bsj + w0 * x0[j] + w1 * x1[j] + w2 * x2[j] + w3 * x3[j]; v1[j] = bsj + w0 * x1[j] + w1 * x2[j] + w2 * x3[j] + w3 * x4[j]; }
          u32x4 o; o.x = pk2(v0[0], v0[1]); o.y = pk2(v0[2], v0[3]); o.z = pk2(v0[4], v0[5]); o.w = pk2(v0[6], v0[7]); *(LAS u32x4*)(L + O_LX + t0 * LP + cgi * 16) = o;
          o.x = pk2(v1[0], v1[1]); o.y = pk2(v1[2], v1[3]); o.z = pk2(v1[4], v1[5]); o.w = pk2(v1[6], v1[7]); *(LAS u32x4*)(L + O_LX + (t0 + 1) * LP + cgi * 16) = o;
          *(LAS f32x4*)(xf + t0 * 64 + cgi * 8) = (f32x4){v0[0], v0[1], v0[2], v0[3]}; *(LAS f32x4*)(xf + t0 * 64 + cgi * 8 + 4) = (f32x4){v0[4], v0[5], v0[6], v0[7]};
          *(LAS f32x4*)(xf + (t0 + 1) * 64 + cgi * 8) = (f32x4){v1[0], v1[1], v1[2], v1[3]}; *(LAS f32x4*)(xf + (t0 + 1) * 64 + cgi * 8 + 4) = (f32x4){v1[4], v1[5], v1[6], v1[7]}; }
        WGBAR();
        { bf16x8 xa[2];
#pragma unroll
          for (int ks = 0; ks < 2; ++ks) xa[ks] = ldsA(L + O_LX + (16 * w + r16) * LP + (32 * ks + 8 * g4) * 2);
          float xv[4][4];
#pragma unroll
          for (int jt = 0; jt < 4; ++jt)
#pragma unroll
              for (int r = 0; r < 4; ++r) xv[jt][r] = xf[(16 * w + 4 * g4 + r) * 64 + 16 * jt + r16];
#pragma unroll
          for (int jt = 0; jt < 4; ++jt) { f32x4 R = (f32x4){0.f, 0.f, 0.f, 0.f}, I = R;
#pragma unroll
              for (int ks = 0; ks < 2; ++ks) { R = MFMA16(xa[ks], ldsA(L + O_WA + (16 * jt + r16) * LP + (32 * ks + 8 * g4) * 2), R); I = MFMA16(xa[ks], ldsA(L + O_WX + (16 * jt + r16) * LP + (32 * ks + 8 * g4) * 2), I); }
#pragma unroll
              for (int r = 0; r < 4; ++r) { const int t = 16 * w + 4 * g4 + r, j = 16 * jt + r16;
                  const float rg = sigmoidf_(R[r] + ba[jt]), ig = sigmoidf_(I[r] + bx[jt]); const float la = -8.f * rg * spl[jt];
                  const float a = __expf(la), mult = __builtin_amdgcn_sqrtf(fmaxf(1.f - a * a, 0.f));
                  a_s[t * 64 + j] = a; u_s[t * 64 + j] = mult * ig * xv[jt][r]; } } }
        WGBAR();
        { float hh = 0.f, pp = 1.f; float av[16], uv[16];
#pragma unroll
          for (int i = 0; i < 16; ++i) { av[i] = a_s[(16 * w + i) * 64 + lane]; uv[i] = u_s[(16 * w + i) * 64 + lane]; }
#pragma unroll
          for (int i = 0; i < 16; ++i) { hh = av[i] * hh + uv[i]; pp *= av[i]; uv[i] = hh; av[i] = pp; }
#pragma unroll
          for (int i = 0; i < 16; ++i) { u_s[(16 * w + i) * 64 + lane] = uv[i]; a_s[(16 * w + i) * 64 + lane] = av[i]; }
          segH[w * 64 + lane] = hh; segP[w * 64 + lane] = pp; }
        WGBAR();
        { float cin = carry, call = carry;
#pragma unroll
          for (int q = 0; q < 8; ++q) { const float sh = segH[q * 64 + lane], sp = segP[q * 64 + lane]; call = sp * call + sh; if (q < w) cin = call; }
          carry = call;
#pragma unroll 2
          for (int i = 0; i < 16; ++i) { const int t = 16 * w + i; const size_t row = (size_t)(row0 + t);
              const float hv = u_s[t * 64 + lane] + a_s[t * 64 + lane] * cin;
              const float gt = bf2f(*(const LAS unsigned short*)(L + O_GT + t * 128 + lane * 2)); const float yo = hv * gelu_tanhf_(gt);
              ybuf[row * DM + 384 + 64 * g + lane] = (bf16_t)f2bf(yo);
              const float s = wave_sum64(yo * yo); if (lane == 0) unsafeAtomicAdd(rss + row, s); } }
        WGBAR();
    }
}

constexpr int KP = 144;
constexpr int O_NB = 0, O_KV = 8192, KVB = 64 * KP  , O_RED = O_KV + 8 * KVB;
static_assert(O_RED + 256 <= LDS_BYTES - 64, "fox lds");
DEV void fox_tile(const lptr Kb, const lptr Vb, const LAS float* nb, const bf16x8 (&qf)[2][2], f32x4 (&o)[4][2], float (&mrun)[2], f32x4 (&lacc)[2], int kv0, int q0, int r16, int g4) {
        if (kv0 <= q0 + 31) {
        bf16x8 kf[4][2]; f32x4 bias[4];
#pragma unroll
        for (int kt = 0; kt < 4; ++kt) {
#pragma unroll
            for (int ks = 0; ks < 2; ++ks) kf[kt][ks] = ldsA(Kb + (16 * kt + r16) * KP + (32 * ks + 8 * g4) * 2);
            bias[kt] = *(const LAS f32x4*)(nb + kv0 + 16 * kt + 4 * g4); }
        f32x4 s[4][2];
        __builtin_amdgcn_s_setprio(1);
#pragma unroll
        for (int kt = 0; kt < 4; ++kt) { s[kt][0] = bias[kt]; s[kt][1] = bias[kt];
#pragma unroll
            for (int ks = 0; ks < 2; ++ks) { s[kt][0] = MFMA16(kf[kt][ks], qf[0][ks], s[kt][0]); s[kt][1] = MFMA16(kf[kt][ks], qf[1][ks], s[kt][1]); } }
        __builtin_amdgcn_s_setprio(0);
        bf16x8 vf[2][4];
#pragma unroll
        for (int k2 = 0; k2 < 2; ++k2)
#pragma unroll
            for (int dt = 0; dt < 4; ++dt) { const lptr va = Vb + (32 * k2 + 4 * g4 + (r16 >> 2)) * KP + (16 * dt + 4 * (r16 & 3)) * 2; vf[k2][dt] = vtr8(va, va + 16 * KP); }
        __builtin_amdgcn_sched_barrier(0);
        const bool diag = (kv0 + 63 > q0);
        float mnew[2] = {mrun[0], mrun[1]};
        if (diag) {
#pragma unroll
            for (int kt = 0; kt < 4; ++kt)
#pragma unroll
                for (int qt = 0; qt < 2; ++qt)
#pragma unroll
                    for (int r = 0; r < 4; ++r) { const int kv = kv0 + 16 * kt + 4 * g4 + r, q = q0 + 16 * qt + r16; if (kv > q) s[kt][qt][r] = -INFINITY; }
        }
#pragma unroll
        for (int kt = 0; kt < 4; ++kt)
#pragma unroll
            for (int qt = 0; qt < 2; ++qt)
#pragma unroll
                for (int r = 0; r < 4; ++r) mnew[qt] = fmaxf(mnew[qt], s[kt][qt][r]);
        float alpha[2];
#pragma unroll
        for (int qt = 0; qt < 2; ++qt) { float m = mnew[qt]; m = fmaxf(m, __shfl_xor(m, 16));
            { const auto rr = __builtin_amdgcn_permlane32_swap(__float_as_uint(m), __float_as_uint(m), false, false); m = fmaxf(__uint_as_float(rr[0]), __uint_as_float(rr[1])); }
            mnew[qt] = m; alpha[qt] = ex2_(mrun[qt] - m); }
        const bool grew = __any((mnew[0] > mrun[0]) || (mnew[1] > mrun[1]));
        mrun[0] = mnew[0]; mrun[1] = mnew[1];
#pragma unroll
        for (int kt = 0; kt < 4; ++kt)
#pragma unroll
            for (int qt = 0; qt < 2; ++qt)
#pragma unroll
                for (int r = 0; r < 4; ++r) s[kt][qt][r] = ex2_(s[kt][qt][r] - mnew[qt]);
        if (grew) {
#pragma unroll
            for (int qt = 0; qt < 2; ++qt) { lacc[qt] *= alpha[qt];
#pragma unroll
                for (int dt = 0; dt < 4; ++dt) o[dt][qt] *= alpha[qt]; } }
        const bf16x8 ones = (bf16x8){0x3f80, 0x3f80, 0x3f80, 0x3f80, 0x3f80, 0x3f80, 0x3f80, 0x3f80};
#pragma unroll
        for (int k2 = 0; k2 < 2; ++k2) {
            bf16x8 pb[2];
#pragma unroll
            for (int qt = 0; qt < 2; ++qt) { const f32x4 a = s[2 * k2][qt], bq = s[2 * k2 + 1][qt];
                const u32x4 wv = (u32x4){pk2(a[0], a[1]), pk2(a[2], a[3]), pk2(bq[0], bq[1]), pk2(bq[2], bq[3])}; pb[qt] = __builtin_bit_cast(bf16x8, wv); }
            __builtin_amdgcn_s_setprio(1);
#pragma unroll
            for (int dt = 0; dt < 4; ++dt) { o[dt][0] = MFMA16(vf[k2][dt], pb[0], o[dt][0]); o[dt][1] = MFMA16(vf[k2][dt], pb[1], o[dt][1]); }
            lacc[0] = MFMA16(ones, pb[0], lacc[0]); lacc[1] = MFMA16(ones, pb[1], lacc[1]); __builtin_amdgcn_s_setprio(0);
        }
    }
}
DEV void fox_qblock(const Ctx& c, int layer, int b, int h, int qb) {
    const lptr L = c.L; const int tid = c.tid, lane = c.lane, w = c.wave, r16 = lane & 15, g4 = lane >> 4;
    const bf16_t* proj = c.bfp(WS_PROJ); bf16_t* ybuf = c.bfp(WS_Y); float* rss = c.rs(RS_FOX + layer);
    const LAS float* nb = (const LAS float*)(L + O_NB);
    const int q0 = qb * 256 + w * 32;
    const size_t rowb = (size_t)b * SEQ;
    bf16x8 qf[2][2];
#pragma unroll
    for (int qt = 0; qt < 2; ++qt)
#pragma unroll
        for (int ks = 0; ks < 2; ++ks) { const u32x4 raw = *(const u32x4*)(proj + (rowb + q0 + 16 * qt + r16) * NPROJ + C_Q + h * 64 + 32 * ks + 8 * g4);
            float qv[8]; unpack8(raw, qv); constexpr float C1 = 0.125f * 1.4426950408889634f;
            const u32x4 qs = (u32x4){pk2(qv[0] * C1, qv[1] * C1), pk2(qv[2] * C1, qv[3] * C1), pk2(qv[4] * C1, qv[5] * C1), pk2(qv[6] * C1, qv[7] * C1)}; qf[qt][ks] = __builtin_bit_cast(bf16x8, qs); }
    f32x4 o[4][2];
#pragma unroll
    for (int dt = 0; dt < 4; ++dt) { o[dt][0] = (f32x4){0.f, 0.f, 0.f, 0.f}; o[dt][1] = o[dt][0]; }
    float mrun[2] = {-INFINITY, -INFINITY}; f32x4 lacc[2] = {(f32x4){0.f, 0.f, 0.f, 0.f}, (f32x4){0.f, 0.f, 0.f, 0.f}};
    const int NTS = 2 * (qb + 1);
    const int srow = tid >> 3, sch = tid & 7;
    const bf16_t* ksrc = proj + (rowb + srow) * NPROJ + C_K + h * 64 + sch * 8;
    const bf16_t* vsrc = proj + (rowb + srow) * NPROJ + C_V + h * 64 + sch * 8;
    const lptr st0 = L + O_KV + srow * KP + sch * 16, st1 = st0 + 4 * KVB;
#define FOX_LOAD(KA, VA, KB2, VB2, ts_) do { const int tn_ = ((ts_) < NTS) ? (ts_) : NTS - 1; \
        KA = *(const u32x4*)(ksrc + (size_t)tn_ * 128 * NPROJ); VA = *(const u32x4*)(vsrc + (size_t)tn_ * 128 * NPROJ); \
        KB2 = *(const u32x4*)(ksrc + ((size_t)tn_ * 128 + 64) * NPROJ); VB2 = *(const u32x4*)(vsrc + ((size_t)tn_ * 128 + 64) * NPROJ); } while (0)
#define FOX_STORE(st_, KA, VA, KB2, VB2) do { *(LAS u32x4*)(st_) = KA; *(LAS u32x4*)((st_) + KVB) = VA; *(LAS u32x4*)((st_) + 2 * KVB) = KB2; *(LAS u32x4*)((st_) + 3 * KVB) = VB2; } while (0)
    u32x4 kA0, vA0, kA1, vA1, kB0, vB0, kB1, vB1;
    FOX_LOAD(kB0, vB0, kB1, vB1, 0);
    FOX_LOAD(kA0, vA0, kA1, vA1, 1);
    FOX_STORE(st0, kB0, vB0, kB1, vB1);
    WGBAR();
    for (int ts = 0; ts < NTS; ts += 2) {
        FOX_LOAD(kB0, vB0, kB1, vB1, ts + 2);
        __builtin_amdgcn_sched_barrier(0);
        fox_tile(L + O_KV, L + O_KV + KVB, nb, qf, o, mrun, lacc, ts * 128, q0, r16, g4);
        fox_tile(L + O_KV + 2 * KVB, L + O_KV + 3 * KVB, nb, qf, o, mrun, lacc, ts * 128 + 64, q0, r16, g4);
        FOX_STORE(st1, kA0, vA0, kA1, vA1);
        WGBAR();
        FOX_LOAD(kA0, vA0, kA1, vA1, ts + 3);
        __builtin_amdgcn_sched_barrier(0);
        fox_tile(L + O_KV + 4 * KVB, L + O_KV + 5 * KVB, nb, qf, o, mrun, lacc, (ts + 1) * 128, q0, r16, g4);
        fox_tile(L + O_KV + 6 * KVB, L + O_KV + 7 * KVB, nb, qf, o, mrun, lacc, (ts + 1) * 128 + 64, q0, r16, g4);
        FOX_STORE(st0, kB0, vB0, kB1, vB1);
        WGBAR();
    }
#undef FOX_LOAD
#undef FOX_STORE
#pragma unroll
    for (int qt = 0; qt < 2; ++qt) { const float rl = 1.f / lacc[qt][0];
        const size_t row = rowb + q0 + 16 * qt + r16; float ss = 0.f;
#pragma unroll
        for (int dt = 0; dt < 4; ++dt) { const f32x4 v = o[dt][qt] * rl; u32x2 wv; wv.x = cvt_pk_bf16(v[0], v[1]); wv.y = cvt_pk_bf16(v[2], v[3]);
            *(u32x2*)(ybuf + row * DM + 640 + h * 64 + 16 * dt + 4 * g4) = wv; ss += (v[0] * v[0] + v[1] * v[1]) + (v[2] * v[2] + v[3] * v[3]); }
        ss += __shfl_xor(ss, 16); ss += __shfl_xor(ss, 32);
        if (g4 == 0) unsafeAtomicAdd(rss + row, ss); }
}
DEV void fox_unit(const Ctx& c, int layer, int b, int h, int pair) {
    const lptr L = c.L; const int tid = c.tid, lane = c.lane, w = c.wave;
    const float* side = (const float*)(c.ws + WS_SIDE); const float bf = c.in[18][layer * 6 + h];
    LAS float* nb = (LAS float*)(L + O_NB); LAS float* red = (LAS float*)(L + O_RED);
    { float v[4]; float run = 0.f;
#pragma unroll
      for (int i = 0; i < 4; ++i) { const float x = side[((size_t)b * SEQ + 4 * tid + i) * 16 + 6 + h] + bf; run += -softplusf_(-x); v[i] = run; }
      float s = run;
#pragma unroll
      for (int o = 1; o < 64; o <<= 1) { const float t = __shfl_up(s, o); if (lane >= o) s += t; }
      if (lane == 63) red[w] = s;
      WGBAR();
      float base = s - run;
#pragma unroll
      for (int q = 0; q < 8; ++q) if (q < w) base += red[q];
#pragma unroll
      for (int i = 0; i < 4; ++i) nb[4 * tid + i] = -1.4426950408889634f * (base + v[i]);
      WGBAR(); }
    fox_qblock(c, layer, b, h, 7 - pair);
    fox_qblock(c, layer, b, h, pair);
    WGBAR();
}

#ifndef MXMASK
#define MXMASK 7
#endif
DEV Ctx relaunder(const Ctx& c0) { Ctx c = c0; { const __attribute__((address_space(4))) char* k = (const __attribute__((address_space(4))) char*)__builtin_amdgcn_kernarg_segment_ptr(); asm volatile("" : "+s"(k)); c.in.kp = k; }
    { unsigned l = (unsigned)(unsigned long long)c0.L; asm volatile("" : "+s"(l)); c.L = (lptr)l; }
    int t = threadIdx.x; asm volatile("" : "+v"(t)); c.tid = t; c.lane = t & 63; c.wave = __builtin_amdgcn_readfirstlane(t >> 6);
    unsigned long long w = (unsigned long long)c0.ws; asm volatile("" : "+s"(w)); c.ws = (unsigned char*)(__attribute__((address_space(1))) unsigned char*)w;
    unsigned long long o = (unsigned long long)c0.out; asm volatile("" : "+s"(o)); c.out = (float*)(__attribute__((address_space(1))) float*)o; return c; }
struct OneUnit { int pm, pn;
    DEV bool next(int i, Unit& u) const { if (i) return false; u.pm = pm; u.pn = pn; return true; }
    DEV void a_ready(const Unit&) const {}
    DEV void done(const Unit&) const {} };
#ifndef SPINUNIT
#define SPINUNIT 0
#endif
DEV void mixer_phase(const Ctx& c0, int layer) {
    constexpr int N_SSD = NB * 6, N_LRU = NB * 4, N_FOX = NB * 6 * 4, N_ALL = N_SSD + N_LRU + N_FOX;
    constexpr int N_WT1 = (P0_I_L + 7) / 8, N_P1 = (MTOK * PLE / 8) / 4096;
    const int N_END = N_ALL + 1024 + (layer == 0 ? N_WT1 + N_P1 : 0);
    unsigned* ctr = (unsigned*)(c0.ws + WS_CTL) + 64 * layer;
    LAS int* slot = (LAS int*)(c0.L + LDS_BYTES - 16);
    unsigned pend = 0u;
    if (c0.tid == 0) pend = atomicAdd(ctr, 1u);
    for (;;) {
        const Ctx c = relaunder(c0);
        WGBAR();
        if (c.tid == 0) *slot = (int)pend;
        WGBAR();
        const int u = __builtin_amdgcn_readfirstlane(*slot);
        if (c.tid == 0 && u < N_END) pend = atomicAdd(ctr, 1u);
        if (u >= N_END) break;
        if (u >= N_ALL + 1024) {
            const int v = u - (N_ALL + 1024);
            if (v < N_WT1) { const int r = v * 8 + c.wave; if (r < P0_I_L) p0_weight_item(c, 1, r); }
            else p0_p_items(c, 1, (v - N_WT1) * 4096);
            continue; }
        if (u >= N_ALL) {
            const int v = u - N_ALL; int kpp = PLE; asm volatile("" : "+s"(kpp));
            pg8::Gemm g{c.bfp(WS_PB) + (size_t)layer * MTOK * PLE, c.bfp(WS_WPP) + (size_t)layer * 1024 * PLE, MTOK, 1024, kpp}; OneUnit S{v >> 2, v & 3};
            EpiPP E{c.bfp(WS_PP)};
            pg8::gemm_phase<EpiPP, OneUnit, false, true>((PG8_LAS unsigned char*)c.L, g, S, E);
            continue; }
#if SPINUNIT
        const unsigned long long tu0 = __builtin_amdgcn_s_memrealtime();
#endif
        if (u < N_SSD) { if (MXMASK & 1) ssd_unit(c, layer, u / 6, u % 6); }
        else if (u < N_SSD + N_LRU) { const int v = u - N_SSD; if (MXMASK & 2) lru_unit(c, layer, v >> 2, v & 3); }
        else { const int v = u - N_SSD - N_LRU; if (MXMASK & 4) fox_unit(c, layer, v / 24, (v % 24) >> 2, v & 3); }
#if SPINUNIT
        { const int ty = (u < N_SSD) ? 1 : (u < N_SSD + N_LRU ? 2 : 4); if ((SPINUNIT & ty) && c.tid == 0) atomicAdd((unsigned*)(c0.ws + WS_CTL) + 128, (unsigned)(__builtin_amdgcn_s_memrealtime() - tu0)); }
#endif
    }
}
DEV void ynorm_phase(const Ctx& c, int layer) {
    u32x4* y = (u32x4*)c.bfp(WS_Y); const float* r0 = c.rs(RS_SSD + layer); const float* r1 = c.rs(RS_LRU + layer); const float* r2 = c.rs(RS_FOX + layer);
    const int gt = c.bid * 512 + c.tid, NGT = c.G * 512;
    for (int i0 = gt; i0 < MTOK * 128; i0 += 8 * NGT) { u32x4 yv[8]; float ss[8];
#pragma unroll
        for (int q = 0; q < 8; ++q) { const int i = i0 + q * NGT, row = i >> 7, c8 = i & 127; yv[q] = y[i];
            const float* rp = (c8 < 48) ? r0 : (c8 < 80 ? r1 : r2); ss[q] = rp[row] * ((c8 >= 48 && c8 < 80) ? (1.f / 256.f) : (1.f / 384.f)); }
#pragma unroll
        for (int q = 0; q < 8; ++q) { const float sc = rsqrtf(ss[q] + EPSN); float v[8]; unpack8(yv[q], v);
            u32x4 o; o.x = pk2(v[0] * sc, v[1] * sc); o.y = pk2(v[2] * sc, v[3] * sc); o.z = pk2(v[4] * sc, v[5] * sc); o.w = pk2(v[6] * sc, v[7] * sc); y[i0 + q * NGT] = o; } }
}
DEV void final_phase(const Ctx& c) {
    f32x4* o = (f32x4*)c.out; const u32x4* h = (const u32x4*)c.bfp(WS_HBA); const float* rs = c.rs(RS_FINAL); const f32x4* g = (const f32x4*)c.in[29];
    const int gt = c.bid * 512 + c.tid, NGT = c.G * 512;
    for (int i0 = gt; i0 < MTOK * 128; i0 += 8 * NGT) { u32x4 hv[8]; float ss[8];
#pragma unroll
        for (int q = 0; q < 8; ++q) { const int i = i0 + q * NGT; hv[q] = h[i]; ss[q] = rs[i >> 7]; }
#pragma unroll
        for (int q = 0; q < 8; ++q) { const int i = i0 + q * NGT, c8 = i & 127; const float sc = rsqrtf(ss[q] * (1.f / 1024.f) + EPSN);
            float v[8]; unpack8(hv[q], v); const f32x4 g0 = g[2 * c8], g1 = g[2 * c8 + 1];
            __builtin_nontemporal_store((f32x4){v[0] * sc * g0[0], v[1] * sc * g0[1], v[2] * sc * g0[2], v[3] * sc * g0[3]}, o + 2 * (size_t)i); __builtin_nontemporal_store((f32x4){v[4] * sc * g1[0], v[5] * sc * g1[1], v[6] * sc * g1[2], v[7] * sc * g1[3]}, o + 2 * (size_t)i + 1); } }
}

#define XB_TMO      128
#define XB_XCNT(j)  (256  + 64 * (j))
#define XB_XSUB(j)  (1280 + 64 * (j))
#define XB_XGEN(j)  (2304 + 64 * (j))
#define XB_TOP      3328
#define XB_TOPGEN   3392
#define XCD_BAR_WORDS 3456
#define XB_SPIN_CAP (1u << 18)

__device__ __forceinline__ unsigned xb_ld(unsigned* p)              { return __hip_atomic_load(p, __ATOMIC_RELAXED, __HIP_MEMORY_SCOPE_AGENT); }
__device__ __forceinline__ unsigned xb_add(unsigned* p, unsigned v) { return __hip_atomic_fetch_add(p, v, __ATOMIC_RELAXED, __HIP_MEMORY_SCOPE_AGENT); }
__device__ __forceinline__ unsigned xb_xcc_id() { return (unsigned)__builtin_amdgcn_s_getreg((3 << 11) | 20) & 0xFu; }
#define XB_SPIN(cond, bar) do { unsigned _sp = 0; while (cond) { __builtin_amdgcn_s_sleep(1); \
    if ((++_sp & 255u) == 0u) { if (xb_ld(&(bar)[XB_TMO])) break; if (_sp > XB_SPIN_CAP) { atomicAdd(&(bar)[XB_TMO], 1u); break; } } } } while (0)

struct XcdBarrier {
    unsigned* bar; unsigned x;
    volatile LAS unsigned* st;
};

__device__ __forceinline__ XcdBarrier xcd_barrier_post(unsigned* bar, volatile LAS unsigned* st) {
    XcdBarrier b; b.bar = bar; b.x = xb_xcc_id(); b.st = st;
    if (threadIdx.x == 0) (void)xb_add(&bar[XB_XCNT(b.x)], 1u);
    return b;
}
__device__ __forceinline__ void xcd_barrier_complete(unsigned* bar, unsigned x, unsigned& nloc, unsigned& nx) {
    const unsigned G = gridDim.x * gridDim.y * gridDim.z;
    unsigned sum, cnt, mine, sp = 0u;
    for (;;) {
        sum = 0u; cnt = 0u; mine = 0u;
#pragma unroll
        for (unsigned j = 0; j < 16; ++j) { const unsigned c = xb_ld(&bar[XB_XCNT(j)]); sum += c; cnt += (c > 0u) ? 1u : 0u; mine = (j == x) ? c : mine; }
        if (sum == G) break;
        __builtin_amdgcn_s_sleep(1);
        if ((++sp & 255u) == 0u) { if (xb_ld(&bar[XB_TMO])) break; if (sp > XB_SPIN_CAP) { atomicAdd(&bar[XB_TMO], 1u); break; } }
    }
    nloc = mine > 0u ? mine : 1u; nx = cnt > 0u ? cnt : 1u;
}

__device__ __forceinline__ void xcd_barrier(const XcdBarrier& b) {
    asm volatile("s_waitcnt vmcnt(0)" ::: "memory");
    __syncthreads();
    if (threadIdx.x == 0) {
        unsigned* bar = b.bar;
        __builtin_amdgcn_s_waitcnt(0);
        unsigned nloc = b.st[0], nx = b.st[1];
        if (nloc == 0u) { xcd_barrier_complete(bar, b.x, nloc, nx); b.st[0] = nloc; b.st[1] = nx; }
        const unsigned old = xb_add(&bar[XB_XSUB(b.x)], 1u);
        const unsigned gen = old / nloc;
        if (old + 1u == (gen + 1u) * nloc) {
            __builtin_amdgcn_fence(__ATOMIC_RELEASE, "agent");
            asm volatile("s_waitcnt vmcnt(0)" ::: "memory");
            const unsigned og = xb_add(&bar[XB_TOP], 1u);
            const unsigned tg = og / nx;
            if (og + 1u == (tg + 1u) * nx) xb_add(&bar[XB_TOPGEN], 1u);
            else XB_SPIN(xb_ld(&bar[XB_TOPGEN]) == tg, bar);
            __builtin_amdgcn_fence(__ATOMIC_ACQUIRE, "agent");
            xb_add(&bar[XB_XGEN(b.x)], 1u);
            asm volatile("s_waitcnt vmcnt(0)" ::: "memory");
        } else {
            XB_SPIN(xb_ld(&bar[XB_XGEN(b.x)]) == gen, bar);
            __builtin_amdgcn_fence(__ATOMIC_ACQUIRE, "agent");
            asm volatile("s_waitcnt vmcnt(0)" ::: "memory");
        }
    }
    __syncthreads();
}

constexpr int N_PHASES = 16;
#ifndef SPINMASK
#define SPINMASK 0
#endif
#ifndef SPINSYNC
#define SPINSYNC 0
#endif
#ifndef PHMASK
#define PHMASK 511
#endif
__global__ void __launch_bounds__(512, 2) trunk_fwd(Args args) {
    extern __shared__ __attribute__((aligned(16))) unsigned char lds[];
    cg::grid_group grid = cg::this_grid();
    Ctx c;
    c.in.kp = (const __attribute__((address_space(4))) char*)__builtin_amdgcn_kernarg_segment_ptr(); c.out = args.out; c.ws = args.ws; c.L = (lptr)lds; c.tid = threadIdx.x; c.lane = c.tid & 63; c.wave = __builtin_amdgcn_readfirstlane(c.tid >> 6); c.G = gridDim.x; c.bid = blockIdx.x;
    const Ctx cbase = c;
    volatile LAS unsigned* xb_st = (volatile LAS unsigned*)((lptr)lds + LDS_BYTES - 32);
    if (threadIdx.x == 0) { xb_st[0] = 0u; xb_st[1] = 0u; }
    __syncthreads();
    const XcdBarrier xbar = xcd_barrier_post((unsigned*)(args.ws + WS_CTL) + 8192, xb_st);
#if SPINMASK
    unsigned long long spin_acc = 0ull;
#endif
    for (int ph = args.ph_lo; ph < args.ph_hi; ++ph) {
        c = relaunder(cbase);
#if SPINMASK
        const unsigned long long t_ph0 = __builtin_amdgcn_s_memrealtime();
#endif
        if (ph == 0) { if (PHMASK & 1) p0_prologue(c); }
        else if (ph == N_PHASES - 1) { if (PHMASK & 2) final_phase(c); }
        else {
            const int l = (ph - 1) / 7, sp = (ph - 1) % 7;
            bf16_t* const hcur = (l == 0) ? c.bfp(WS_HBA) : (bf16_t*)c.out;
            bf16_t* const hnxt = (l == 0) ? (bf16_t*)c.out : c.bfp(WS_HBA);
            if (sp == 0) { if (PHMASK & 4) {
                pg8::Gemm g{hcur, c.bfp(WS_WIN) + (size_t)l * NPROJ * 1024, MTOK, NPROJ, 1024}; pg8::StaticOrder S; S.init(MTOK, NPROJ, c.G, c.bid);
                EpiProj E{c.bfp(WS_PROJ), c.rs(l == 0 ? RS_IN0 : RS_IN1), (float*)(c.ws + WS_SIDE)};
                pg8::gemm_phase<EpiProj, pg8::StaticOrder, true, true>((PG8_LAS unsigned char*)lds, g, S, E); }
            } else if (sp == 1) { if (PHMASK & 8) mixer_phase(c, l);
            }

            else if (sp == 2) {
                if (PHMASK & 16) ynorm_phase(c, l);
            } else if (sp == 3) { if (PHMASK & 32) {
                pg8::Gemm g{c.bfp(WS_Y), c.bfp(WS_WOUT) + (size_t)l * 1024 * 1024, MTOK, 1024, 1024}; pg8::StaticOrder S; S.init(MTOK, 1024, c.G, c.bid);
                EpiResid E{hcur, hcur, c.rs(RS_N2 + l)};
                pg8::gemm_phase<EpiResid, pg8::StaticOrder, true, true>((PG8_LAS unsigned char*)lds, g, S, E); }
            } else if (sp == 4) { if (PHMASK & 64) {
                pg8::Gemm g{hcur, c.bfp(WS_WGU) + (size_t)l * 5632 * 1024, MTOK, 5632, 1024}; pg8::StaticOrder S; S.init(MTOK, 5632, c.G, c.bid);
                EpiSwiGLU E{c.bfp(WS_PROJ), c.rs(RS_N2 + l)};
                pg8::gemm_phase<EpiSwiGLU, pg8::StaticOrder, true, true>((PG8_LAS unsigned char*)lds, g, S, E); }
            } else if (sp == 5) { if (PHMASK & 128) {
                pg8::Gemm g{c.bfp(WS_PROJ), c.bfp(WS_WDN) + (size_t)l * 1024 * DFF, MTOK, 1024, DFF}; pg8::StaticOrder S; S.init(MTOK, 1024, c.G, c.bid);
                EpiResid E{hcur, hcur, c.rs(RS_N3 + l)};
                pg8::gemm_phase<EpiResid, pg8::StaticOrder, true, true>((PG8_LAS unsigned char*)lds, g, S, E); }
            } else { if (PHMASK & 256) {
                pg8::Gemm g{hcur, c.bfp(WS_WPG) + (size_t)l * 1024 * 1024, MTOK, 1024, 1024}; pg8::StaticOrder S; S.init(MTOK, 1024, c.G, c.bid);
                EpiPle E{hcur, hnxt, c.bfp(WS_PP), c.in[27] + l * 1024, c.rs(RS_N3 + l), c.rs(l == 0 ? RS_IN1 : RS_FINAL)};
                pg8::gemm_phase<EpiPle, pg8::StaticOrder, true, true>((PG8_LAS unsigned char*)lds, g, S, E); }
            }
        }
#if SPINMASK
        const unsigned long long t_ph1 = __builtin_amdgcn_s_memrealtime();
#endif
        if (ph + 1 < args.ph_hi) { if (args.ph_hi < 0) grid.sync(); else xcd_barrier(xbar); }
#if SPINMASK
        { const unsigned long long t_ph2 = __builtin_amdgcn_s_memrealtime(); if ((SPINMASK >> ph) & 1) spin_acc += (SPINSYNC ? (t_ph2 - t_ph1) : (t_ph2 - t_ph0)); }
#endif
    }
#if SPINUNIT
    { const unsigned tot = __hip_atomic_load((unsigned*)(cbase.ws + WS_CTL) + 128, __ATOMIC_RELAXED, __HIP_MEMORY_SCOPE_AGENT); const unsigned long long t_e = __builtin_amdgcn_s_memrealtime(); while (__builtin_amdgcn_s_memrealtime() - t_e < tot / gridDim.x) __builtin_amdgcn_s_sleep(8); }
#endif
#if SPINMASK
    { const unsigned long long t_e = __builtin_amdgcn_s_memrealtime(); while (__builtin_amdgcn_s_memrealtime() - t_e < spin_acc) __builtin_amdgcn_s_sleep(8); }
#endif
}

#ifndef ONE_LAUNCH
#define ONE_LAUNCH 1
#endif
extern "C" void kernel_launch(void* const* d_in, const int* in_sizes, int n_in, void* d_out, int out_size, void* d_ws, size_t ws_size, hipStream_t stream) {
    static int grid = 0;
    if (grid == 0) {
        if (n_in != 30 || out_size != MTOK * DM || ws_size < WS_END) { fprintf(stderr, "kernel_launch: unexpected shapes (n_in %d out %d ws %zu)\n", n_in, out_size, ws_size); grid = -1; return; }
        int dev = 0, cus = 0, per_cu = 0;
        hipGetDevice(&dev); hipDeviceGetAttribute(&cus, hipDeviceAttributeMultiprocessorCount, dev);
        if (hipFuncSetAttribute((const void*)trunk_fwd, hipFuncAttributeMaxDynamicSharedMemorySize, LDS_BYTES) != hipSuccess) { fprintf(stderr, "kernel_launch: hipFuncSetAttribute failed\n"); grid = -1; return; }
        if (hipOccupancyMaxActiveBlocksPerMultiprocessor(&per_cu, (const void*)trunk_fwd, 512, LDS_BYTES) != hipSuccess || per_cu < 1) per_cu = 1;
        (void)hipGetLastError();
        grid = cus * (per_cu > 1 ? 1 : per_cu);
    }
    if (grid < 0) return;
    if (hipMemsetAsync((char*)d_ws + WS_CTL + 32768, 0, 16384, stream) != hipSuccess) { fprintf(stderr, "kernel_launch: hipMemsetAsync failed\n"); return; }
    Args a{};
    for (int i = 0; i < 30; ++i) a.in[i] = (const float*)d_in[i];
    a.out = (float*)d_out; a.ws = (unsigned char*)d_ws;
#if ONE_LAUNCH
    a.ph_lo = 0; a.ph_hi = N_PHASES;
    void* kargs[] = {&a};
    hipError_t e = hipLaunchCooperativeKernel((const void*)trunk_fwd, dim3(grid), dim3(512), kargs, LDS_BYTES, stream);
    if (e != hipSuccess) fprintf(stderr, "cooperative launch failed: %s (grid %d)\n", hipGetErrorString(e), grid);
#else
    for (int ph = 0; ph < N_PHASES; ++ph) { a.ph_lo = ph; a.ph_hi = ph + 1; hipLaunchKernelGGL(trunk_fwd, dim3(grid), dim3(512), LDS_BYTES, stream, a); }
#endif
}
```

```cpp
#include <hip/hip_runtime.h>
#include <cstdio>
#include <cstdint>
namespace pg8 {
#define PG8_LAS __attribute__((address_space(3)))
typedef unsigned short bf16_t;
typedef short bf16x8 __attribute__((ext_vector_type(8)));
typedef float f32x4 __attribute__((ext_vector_type(4)));
typedef unsigned u32x4 __attribute__((ext_vector_type(4)));
constexpr int BM = 256, BK = 64, HALF = 128, HTB = HALF * BK * 2  , STAGE_BYTES = 8 * HTB, NXCD = 8, WGM = 4;

__host__ __device__ __forceinline__ int lds_byte(int r, int c) { const int st = (r >> 4) * 2 + (c >> 5), rr = r & 15, cc = c & 31, ob = rr * 64 + cc * 2; return st * 1024 + (ob ^ (((ob >> 9) & 1) << 5)); }
__host__ __device__ __forceinline__ void stage_rc(int b, int& R, int& C) { const int st = b / 1024, sb = b % 1024, swz = sb ^ (((sb >> 9) & 1) << 5); R = (st >> 1) * 16 + swz / 64; C = (st & 1) * 32 + (swz % 64) / 2; }
__host__ __device__ __forceinline__ int perm32(int rho) { const int n = rho >> 4, i = rho & 15; return 8 * (i >> 2) + 4 * n + (i & 3); }

struct Unit { int pm, pn; };
struct Gemm { const bf16_t* A; const bf16_t* Bt; int M, N, K; };

struct StaticOrder {
    int nM, nN, nwg, G, c;
    __host__ __device__ void init(int M, int N, int G_, int c_) { nM = M / BM; nN = N / BM; nwg = nM * nN; G = G_; c = c_; }
    __host__ __device__ bool next(int i, Unit& u) const {
        const long L = (long)i * G + c; if (L >= nwg) return false;
        int wgid = (int)L; { const int q = nwg / NXCD, r = nwg % NXCD, xcd = wgid % NXCD, off = wgid / NXCD; wgid = (xcd < r ? xcd * (q + 1) : r * (q + 1) + (xcd - r) * q) + off; }
        const int nig = WGM * nN, gid = wgid / nig, fm = gid * WGM, gsz = (nM - fm) < WGM ? (nM - fm) : WGM;
        u.pm = fm + ((wgid % nig) % gsz); u.pn = (wgid % nig) / gsz; return true;
    }
    __device__ __forceinline__ void a_ready(const Unit&) const {}
    __device__ __forceinline__ void done(const Unit&) const {}
};

__device__ __forceinline__ unsigned cvt_pk_bf16(float lo, float hi) { unsigned r; asm volatile("v_cvt_pk_bf16_f32 %0, %1, %2" : "=v"(r) : "v"(lo), "v"(hi)); return r; }
typedef float f32x2 __attribute__((ext_vector_type(2)));
__device__ __forceinline__ f32x2 gelu_pk(f32x2 v) {
    const f32x2 av = __builtin_elementwise_abs(v), d = av * 0.2316418882f + 1.0f;
    f32x2 t; t.x = __builtin_amdgcn_rcpf(d.x); t.y = __builtin_amdgcn_rcpf(d.y);
    f32x2 q = t * 0.5307027145f + (-0.7265760135f); q = q * t + 0.7107068705f; q = q * t + (-0.142248368f); q = q * t + 0.127414796f; q = q * t;
    const f32x2 s = (v * v) * (-0.72134752044f);
    f32x2 e; e.x = __builtin_amdgcn_exp2f(s.x); e.y = __builtin_amdgcn_exp2f(s.y);
    const f32x2 m = v * (q * e), r = v - m;
    f32x2 o; o.x = v.x < 0.f ? m.x : r.x; o.y = v.y < 0.f ? m.y : r.y; return o;
}

template <int ACT  > struct EpiBf16 {
    static constexpr bool PERM = true, AFTER_DRAIN = false; static_assert(ACT == 0 || ACT == 1, "EpiBf16: ACT is 0 (none) or 1 (gelu_pk)");
    bf16_t* O; int ldc; const float* bias; int split_cols; size_t split_stride; float scale0;
    __device__ __forceinline__ void operator()(const f32x4 (&acc)[2][2][4][2], const Unit& u, int wr, int wc, int fr, int fq) const {
        const int row0 = u.pm * BM + wr * 64 + fr; int colt = u.pn * BM; bf16_t* base = O;
        float sc = 1.f; if (split_cols) { const int t = colt / split_cols; base += (size_t)t * split_stride; colt -= t * split_cols; if (t == 0) sc = scale0; }
        const int col0 = colt + wc * 32 + 8 * fq, bcol0 = u.pn * BM + wc * 32 + 8 * fq;
        f32x4 bv[2][2];
#pragma unroll
        for (int bj = 0; bj < 2; ++bj)
#pragma unroll
            for (int n = 0; n < 2; ++n) bv[bj][n] = bias ? *(const f32x4*)(bias + bcol0 + bj * HALF + 4 * n) : (f32x4){0.f, 0.f, 0.f, 0.f};
#pragma unroll
        for (int ai = 0; ai < 2; ++ai)
#pragma unroll
            for (int m = 0; m < 4; ++m) { bf16_t* rowp = base + (size_t)(row0 + ai * HALF + m * 16) * ldc + col0;
#pragma unroll
                for (int bj = 0; bj < 2; ++bj) { f32x4 v0 = acc[ai][bj][m][0] + bv[bj][0], v1 = acc[ai][bj][m][1] + bv[bj][1];
                    if (ACT == 1) { f32x2 a = gelu_pk((f32x2){v0[0], v0[1]}), b = gelu_pk((f32x2){v0[2], v0[3]}), c = gelu_pk((f32x2){v1[0], v1[1]}), d = gelu_pk((f32x2){v1[2], v1[3]});
                        v0 = (f32x4){a.x, a.y, b.x, b.y}; v1 = (f32x4){c.x, c.y, d.x, d.y}; }
                    v0 = v0 * sc; v1 = v1 * sc; u32x4 w; w.x = cvt_pk_bf16(v0[0], v0[1]); w.y = cvt_pk_bf16(v0[2], v0[3]); w.z = cvt_pk_bf16(v1[0], v1[1]); w.w = cvt_pk_bf16(v1[2], v1[3]);
                    *(u32x4*)(rowp + bj * HALF) = w; } }
    }
};
template <class Epi, class Sched, bool ALIGN_EPI = false, bool SP2 = false>
__device__ __forceinline__ void gemm_phase(PG8_LAS unsigned char* lds, const Gemm g, const Sched& S, const Epi& E) {
    int tid_ = threadIdx.x; asm volatile("" : "+v"(tid_));
    const int tid = tid_, wid = __builtin_amdgcn_readfirstlane(tid >> 6), lane = tid & 63, wr = wid >> 2, wc = wid & 3, fr = lane & 15, fq = lane >> 4;
    const int K = g.K, nt = K / BK;
    unsigned voffA[2], voffB[2];
#pragma unroll
    for (int i = 0; i < 2; ++i) { int R, C; stage_rc(tid * 16 + i * 8192, R, C); const int Rb = Epi::PERM ? ((R & ~31) + perm32(R & 31)) : R;
        voffA[i] = (unsigned)(R * K + C) * 2u; voffB[i] = (unsigned)(Rb * K + C) * 2u; }
    const size_t kstep = (size_t)(BK * 2);
    const size_t hstep = (size_t)HALF * K * 2;
    const size_t tstep = 2 * hstep;
    const unsigned ldsw = (unsigned)wid * 1024u;
    const int aoff = lds_byte(wr * 64 + fr, fq * 8), boff = lds_byte(wc * 32 + fr, fq * 8);
#define PG8_SA(b, h) (((b) * 2 + (h)) * HTB)
#define PG8_SB(b, h) ((4 + (b) * 2 + (h)) * HTB)
#define PG8_STAGE(bufoff, gbase, voff) do { _Pragma("unroll") for (int _i = 0; _i < 2; ++_i) \
        __builtin_amdgcn_global_load_lds((const unsigned*)((const char*)(gbase) + (voff)[_i]), (PG8_LAS unsigned*)(lds + (bufoff) + ldsw + _i * 8192), 16, 0, 0); } while (0)
#define PG8_LDA(dst, b, h) do { _Pragma("unroll") for (int m = 0; m < 4; ++m) _Pragma("unroll") for (int k = 0; k < 2; ++k) dst[m][k] = *(const PG8_LAS bf16x8*)(lds + PG8_SA(b, h) + aoff + m * 2048 + k * 1024); } while (0)
#define PG8_LDB(dst, b, h) do { _Pragma("unroll") for (int n = 0; n < 2; ++n) _Pragma("unroll") for (int k = 0; k < 2; ++k) dst[n][k] = *(const PG8_LAS bf16x8*)(lds + PG8_SB(b, h) + boff + n * 2048 + k * 1024); } while (0)
#define PG8_MMA(ai, bj, At, Bt) do { __builtin_amdgcn_s_setprio(1); _Pragma("unroll") for (int m = 0; m < 4; ++m) _Pragma("unroll") for (int n = 0; n < 2; ++n) _Pragma("unroll") for (int k = 0; k < 2; ++k) \
        acc[ai][bj][m][n] = __builtin_amdgcn_mfma_f32_16x16x32_bf16(Bt[n][k], At[m][k], acc[ai][bj][m][n], 0, 0, 0); __builtin_amdgcn_s_setprio(0); } while (0)
#define PG8_WAIT_V(n) asm volatile("s_waitcnt vmcnt(" #n ")" ::: "memory")
#define PG8_WAIT_L(n) asm volatile("s_waitcnt lgkmcnt(" #n ")" ::: "memory")
#define PG8_BAR __builtin_amdgcn_s_barrier()
#define PG8_SCHED __builtin_amdgcn_sched_barrier(0)
    Unit cur, nxt; int ui = 0;
    if (!S.next(0, cur)) return;
    f32x4 acc[2][2][4][2];
#pragma unroll
    for (int a = 0; a < 2; ++a)
#pragma unroll
        for (int b = 0; b < 2; ++b)
#pragma unroll
            for (int m = 0; m < 4; ++m)
#pragma unroll
                for (int n = 0; n < 2; ++n) acc[a][b][m][n] = (f32x4){0.f, 0.f, 0.f, 0.f};
    bf16x8 At[4][2], B0[2][2], B1[2][2];
    const char* cA = (const char*)g.A + (size_t)cur.pm * tstep; const char* cB = (const char*)g.Bt + (size_t)cur.pn * tstep;
    S.a_ready(cur);
    if constexpr (SP2) {
        PG8_STAGE(PG8_SB(0, 0), cB, voffB); PG8_STAGE(PG8_SB(0, 1), cB + hstep, voffB); PG8_STAGE(PG8_SA(0, 0), cA, voffA); PG8_STAGE(PG8_SA(0, 1), cA + hstep, voffA);
        if (wr == 1) PG8_BAR;
        PG8_WAIT_V(2); PG8_BAR;
        PG8_STAGE(PG8_SB(1, 0), cB + kstep, voffB); PG8_STAGE(PG8_SA(1, 0), cA + kstep, voffA); PG8_STAGE(PG8_SB(1, 1), cB + hstep + kstep, voffB);
        PG8_WAIT_V(6); PG8_BAR;
    } else {
        PG8_STAGE(PG8_SB(0, 0), cB, voffB); PG8_STAGE(PG8_SA(0, 0), cA, voffA); PG8_STAGE(PG8_SB(0, 1), cB + hstep, voffB); PG8_STAGE(PG8_SA(0, 1), cA + hstep, voffA);
        if (wr == 1) PG8_BAR;
        PG8_WAIT_V(4); PG8_BAR;
        PG8_STAGE(PG8_SB(1, 0), cB + kstep, voffB); PG8_STAGE(PG8_SA(1, 0), cA + kstep, voffA); PG8_STAGE(PG8_SB(1, 1), cB + hstep + kstep, voffB);
        PG8_WAIT_V(6); PG8_BAR;
    }
    for (;;) {
        const bool has_next = S.next(ui + 1, nxt);
        const char* nA = has_next ? (const char*)g.A + (size_t)nxt.pm * tstep : cA; const char* nB = has_next ? (const char*)g.Bt + (size_t)nxt.pn * tstep : cB;
        for (int t = 0; t < nt; t += 2) {
            const bool last = (t == nt - 2);
            const char* a1 = cA + (size_t)(t + 1) * kstep;
            const char* a2 = last ? nA : cA + (size_t)(t + 2) * kstep; const char* b2 = last ? nB : cB + (size_t)(t + 2) * kstep;
            const char* a3 = a2 + kstep; const char* b3 = b2 + kstep;
            if (last && has_next) S.a_ready(nxt);
            if constexpr (SP2) {
            PG8_LDB(B0, 0, 0); PG8_LDB(B1, 0, 1); PG8_SCHED; PG8_LDA(At, 0, 0); PG8_STAGE(PG8_SA(1, 1), a1 + hstep, voffA);
            PG8_WAIT_V(8); PG8_WAIT_L(0); PG8_BAR; PG8_MMA(0, 0, At, B0); PG8_MMA(0, 1, At, B1); PG8_BAR; PG8_SCHED;
            PG8_LDA(At, 0, 1); PG8_STAGE(PG8_SB(0, 0), b2, voffB); PG8_STAGE(PG8_SB(0, 1), b2 + hstep, voffB); PG8_STAGE(PG8_SA(0, 0), a2, voffA);
            PG8_WAIT_V(8); PG8_WAIT_L(0); PG8_BAR; PG8_MMA(1, 0, At, B0); PG8_MMA(1, 1, At, B1); PG8_BAR; PG8_SCHED;
            PG8_LDB(B0, 1, 0); PG8_LDB(B1, 1, 1); PG8_SCHED; PG8_LDA(At, 1, 0); PG8_STAGE(PG8_SA(0, 1), a2 + hstep, voffA);
            PG8_WAIT_V(8); PG8_WAIT_L(0); PG8_BAR; PG8_MMA(0, 0, At, B0); PG8_MMA(0, 1, At, B1); PG8_BAR; PG8_SCHED;
            PG8_LDA(At, 1, 1); PG8_STAGE(PG8_SB(1, 0), b3, voffB); PG8_STAGE(PG8_SB(1, 1), b3 + hstep, voffB); PG8_STAGE(PG8_SA(1, 0), a3, voffA);
            PG8_WAIT_V(8); PG8_WAIT_L(0); PG8_BAR; PG8_MMA(1, 0, At, B0); PG8_MMA(1, 1, At, B1); PG8_BAR; PG8_SCHED;
            } else {
            PG8_LDB(B0, 0, 0); PG8_SCHED; PG8_LDA(At, 0, 0); PG8_STAGE(PG8_SA(1, 1), a1 + hstep, voffA);
            PG8_WAIT_L(8); PG8_BAR; PG8_WAIT_L(0); PG8_MMA(0, 0, At, B0); PG8_BAR; PG8_SCHED;
            PG8_LDB(B1, 0, 1); PG8_STAGE(PG8_SB(0, 0), b2, voffB);
            PG8_BAR; PG8_WAIT_L(0); PG8_MMA(0, 1, At, B1); PG8_BAR;
            PG8_LDA(At, 0, 1); PG8_STAGE(PG8_SA(0, 0), a2, voffA);
            PG8_BAR; PG8_WAIT_L(0); PG8_MMA(1, 0, At, B0); PG8_BAR; PG8_SCHED;
            PG8_STAGE(PG8_SB(0, 1), b2 + hstep, voffB);
            PG8_WAIT_V(6); PG8_BAR; PG8_MMA(1, 1, At, B1); PG8_BAR;
            PG8_LDB(B0, 1, 0); PG8_SCHED; PG8_LDA(At, 1, 0); PG8_STAGE(PG8_SA(0, 1), a2 + hstep, voffA);
            PG8_WAIT_L(8); PG8_BAR; PG8_WAIT_L(0); PG8_MMA(0, 0, At, B0); PG8_BAR; PG8_SCHED;
            PG8_LDB(B1, 1, 1); PG8_STAGE(PG8_SB(1, 0), b3, voffB);
            PG8_BAR; PG8_WAIT_L(0); PG8_MMA(0, 1, At, B1); PG8_BAR;
            PG8_LDA(At, 1, 1); PG8_STAGE(PG8_SA(1, 0), a3, voffA);
            PG8_BAR; PG8_WAIT_L(0); PG8_MMA(1, 0, At, B0); PG8_BAR; PG8_SCHED;
            PG8_STAGE(PG8_SB(1, 1), b3 + hstep, voffB);
            PG8_WAIT_V(6); PG8_BAR; PG8_MMA(1, 1, At, B1); PG8_BAR;
            }
        }
        if constexpr (ALIGN_EPI) { if (wr == 0) PG8_BAR; }
        if constexpr (!Epi::AFTER_DRAIN) { E(acc, cur, wr, wc, fr, fq); S.done(cur); }
        if (!has_next) break;
#pragma unroll
        for (int a = 0; a < 2; ++a)
#pragma unroll
            for (int b = 0; b < 2; ++b)
#pragma unroll
                for (int m = 0; m < 4; ++m)
#pragma unroll
                    for (int n = 0; n < 2; ++n) acc[a][b][m][n] = (f32x4){0.f, 0.f, 0.f, 0.f};
        cur = nxt; cA = nA; cB = nB; ++ui;
        if constexpr (ALIGN_EPI) { if (wr == 1) PG8_BAR; }
    }
    PG8_WAIT_V(0);
    if constexpr (!ALIGN_EPI) { if (wr == 0) PG8_BAR; }
    PG8_BAR;
    if constexpr (Epi::AFTER_DRAIN) { E.fused(acc, cur, wr, wc, fr, fq, lds, wid, lane); S.done(cur); }
#undef PG8_SA
#undef PG8_SB
#undef PG8_STAGE
#undef PG8_LDA
#undef PG8_LDB
#undef PG8_MMA
#undef PG8_WAIT_V
#undef PG8_WAIT_L
#undef PG8_BAR
#undef PG8_SCHED
}
}

#include <hip/hip_cooperative_groups.h>
namespace cg = cooperative_groups;

#define DEV __device__ __forceinline__
#define LAS __attribute__((address_space(3)))
typedef LAS unsigned char* lptr;
typedef unsigned short bf16_t;
typedef short bf16x8 __attribute__((ext_vector_type(8)));
typedef float f32x4 __attribute__((ext_vector_type(4)));
typedef unsigned u32x4 __attribute__((ext_vector_type(4)));
typedef unsigned u32x2 __attribute__((ext_vector_type(2)));
typedef short v4i16_t __attribute__((ext_vector_type(4)));

constexpr int NB = 32, SEQ = 2048, DM = 1024, MTOK = NB * SEQ;
constexpr int NPROJ = 3072, DFF = 2816, PLE = 256;
constexpr int NLAYER = 2;
constexpr float EPSN = 1e-6f;
constexpr int C_Z = 0, C_X = 384, C_B = 768, C_C = 1024, C_LX = 1280, C_LG = 1536, C_Q = 1792, C_K = 2176, C_V = 2560, C_DT = 2944;

constexpr size_t MiB = 1u << 20;
constexpr size_t WS_CTL = 0;
constexpr size_t WS_RS = 1 * MiB;
constexpr size_t WS_SIDE = 5 * MiB;
constexpr size_t WS_WIN = 9 * MiB;
constexpr size_t WS_WOUT = 21 * MiB;
constexpr size_t WS_WGU = 25 * MiB;
constexpr size_t WS_WDN = 47 * MiB;
constexpr size_t WS_WPG = 58 * MiB;
constexpr size_t WS_WPP = 62 * MiB;
constexpr size_t WS_HBA = 64 * MiB;
constexpr size_t WS_Y = 192 * MiB;
constexpr size_t WS_PP = 320 * MiB;
constexpr size_t WS_PB = 448 * MiB;
constexpr size_t WS_PROJ = 512 * MiB;
constexpr size_t WS_END = 896 * MiB;
enum { RS_IN0 = 0, RS_IN1 = 1, RS_FINAL = 2, RS_N2 = 3  , RS_N3 = 5, RS_SSD = 7, RS_LRU = 9, RS_FOX = 11, RS_COUNT = 13 };

constexpr int LDS_BYTES = 163840;

struct Args { const float* in[30]; float* out; unsigned char* ws; int ph_lo, ph_hi; };

DEV unsigned pk2(float lo, float hi) { unsigned r; asm("v_cvt_pk_bf16_f32 %0, %1, %2" : "=v"(r) : "v"(lo), "v"(hi)); return r; }
DEV unsigned f2bf(float f) { return pk2(f, 0.f) & 0xffffu; }
DEV float bf2f(unsigned v) { return __builtin_bit_cast(float, v << 16); }
DEV float bflo(unsigned w) { return __builtin_bit_cast(float, w << 16); }
DEV float bfhi(unsigned w) { return __builtin_bit_cast(float, w & 0xffff0000u); }
DEV float ex2_(float x) { return __builtin_amdgcn_exp2f(x); }
DEV float sigmoidf_(float x) { return __builtin_amdgcn_rcpf(1.f + ex2_(-1.4426950408889634f * x)); }
DEV float siluf_(float x) { return x * sigmoidf_(x); }
DEV float softplusf_(float x) { return fmaxf(x, 0.f) + log1pf(__expf(-fabsf(x))); }
DEV float gelu_tanhf_(float x) { const float u = 0.7978845608028654f * (x + 0.044715f * x * x * x); return x * sigmoidf_(2.f * u); }
DEV void unpack8(const u32x4 r, float (&v)[8]) { v[0] = bflo(r.x); v[1] = bfhi(r.x); v[2] = bflo(r.y); v[3] = bfhi(r.y); v[4] = bflo(r.z); v[5] = bfhi(r.z); v[6] = bflo(r.w); v[7] = bfhi(r.w); }
DEV bf16x8 ldsA(lptr p) { return *(const LAS bf16x8*)p; }
DEV float wave_sum64(float v) {
#pragma unroll
    for (int o = 1; o < 64; o <<= 1) v += __shfl_xor(v, o);
    return v;
}
#define MFMA16(a, b, c) __builtin_amdgcn_mfma_f32_16x16x32_bf16((a), (b), (c), 0, 0, 0)
#define WGBAR() asm volatile("s_waitcnt lgkmcnt(0)\n\ts_barrier" ::: "memory")

using pg8::Unit; using pg8::BM; using pg8::HALF; using pg8::cvt_pk_bf16;

struct EpiProj {
    static constexpr bool PERM = true, AFTER_DRAIN = false;
    bf16_t* O; const float* rowss; float* side;
    __device__ __forceinline__ void operator()(const f32x4 (&acc)[2][2][4][2], const Unit& u, int wr, int wc, int fr, int fq) const {
        const int row0 = u.pm * BM + wr * 64 + fr, col0 = u.pn * BM + wc * 32 + 8 * fq;
        const bool sidew = (u.pn == 11) && (wc == 0) && (fq < 2);
        float rsv[2][4];
#pragma unroll
        for (int ai = 0; ai < 2; ++ai)
#pragma unroll
            for (int m = 0; m < 4; ++m) rsv[ai][m] = rowss[row0 + ai * HALF + m * 16];
#pragma unroll
        for (int ai = 0; ai < 2; ++ai)
#pragma unroll
            for (int m = 0; m < 4; ++m) {
                const int row = row0 + ai * HALF + m * 16; const float rs = rsqrtf(rsv[ai][m] * (1.f / 1024.f) + EPSN);
                bf16_t* rowp = O + (size_t)row * NPROJ + col0;
#pragma unroll
                for (int bj = 0; bj < 2; ++bj) { const f32x4 v0 = acc[ai][bj][m][0] * rs, v1 = acc[ai][bj][m][1] * rs;
                    u32x4 w; w.x = cvt_pk_bf16(v0[0], v0[1]); w.y = cvt_pk_bf16(v0[2], v0[3]); w.z = cvt_pk_bf16(v1[0], v1[1]); w.w = cvt_pk_bf16(v1[2], v1[3]);
                    *(u32x4*)(rowp + bj * HALF) = w;
                    if (bj == 1 && sidew) { *(f32x4*)(side + (size_t)row * 16 + 8 * fq) = v0; if (fq == 0) *(f32x4*)(side + (size_t)row * 16 + 4) = v1; } }
            }
    }
};
struct EpiResid {
    static constexpr bool PERM = true, AFTER_DRAIN = false;
    const bf16_t* hin; bf16_t* hout; float* rowss_out;
    __device__ __forceinline__ void operator()(const f32x4 (&acc)[2][2][4][2], const Unit& u, int wr, int wc, int fr, int fq) const {
        const int row0 = u.pm * BM + wr * 64 + fr, col0 = u.pn * BM + wc * 32 + 8 * fq;
#pragma unroll
        for (int ai = 0; ai < 2; ++ai) {
            u32x4 hr[4][2];
#pragma unroll
            for (int m = 0; m < 4; ++m)
#pragma unroll
                for (int bj = 0; bj < 2; ++bj) hr[m][bj] = *(const u32x4*)(hin + (size_t)(row0 + ai * HALF + m * 16) * DM + col0 + bj * HALF);
#pragma unroll
            for (int m = 0; m < 4; ++m) {
                const int row = row0 + ai * HALF + m * 16; float ss = 0.f;
#pragma unroll
                for (int bj = 0; bj < 2; ++bj) { const size_t off = (size_t)row * DM + col0 + bj * HALF;
                    float hv[8]; unpack8(hr[m][bj], hv);
#pragma unroll
                    for (int j = 0; j < 4; ++j) { hv[j] += acc[ai][bj][m][0][j]; hv[4 + j] += acc[ai][bj][m][1][j]; }
                    u32x4 w; w.x = cvt_pk_bf16(hv[0], hv[1]); w.y = cvt_pk_bf16(hv[2], hv[3]); w.z = cvt_pk_bf16(hv[4], hv[5]); w.w = cvt_pk_bf16(hv[6], hv[7]);
                    *(u32x4*)(hout + off) = w;
#pragma unroll
                    for (int j = 0; j < 8; ++j) ss += hv[j] * hv[j]; }
                ss += __shfl_xor(ss, 16); ss += __shfl_xor(ss, 32);
                if (fq == 0) unsafeAtomicAdd(rowss_out + row, ss);
            }
        }
    }
};
struct EpiSwiGLU {
    static constexpr bool PERM = true, AFTER_DRAIN = false;
    bf16_t* O; const float* rowss;
    __device__ __forceinline__ void operator()(const f32x4 (&acc)[2][2][4][2], const Unit& u, int wr, int wc, int fr, int fq) const {
        const int row0 = u.pm * BM + wr * 64 + fr, col0 = u.pn * HALF + wc * 32 + 8 * fq;
        float rsv[2][4];
#pragma unroll
        for (int ai = 0; ai < 2; ++ai)
#pragma unroll
            for (int m = 0; m < 4; ++m) rsv[ai][m] = rowss[row0 + ai * HALF + m * 16];
#pragma unroll
        for (int ai = 0; ai < 2; ++ai)
#pragma unroll
            for (int m = 0; m < 4; ++m) {
                const int row = row0 + ai * HALF + m * 16; const float rs = rsqrtf(rsv[ai][m] * (1.f / 1024.f) + EPSN);
                float o[8];
#pragma unroll
                for (int n = 0; n < 2; ++n)
#pragma unroll
                    for (int j = 0; j < 4; ++j) { const float g = acc[ai][0][m][n][j] * rs, uu = acc[ai][1][m][n][j] * rs; o[4 * n + j] = siluf_(g) * uu; }
                u32x4 w; w.x = cvt_pk_bf16(o[0], o[1]); w.y = cvt_pk_bf16(o[2], o[3]); w.z = cvt_pk_bf16(o[4], o[5]); w.w = cvt_pk_bf16(o[6], o[7]);
                *(u32x4*)(O + (size_t)row * DFF + col0) = w;
            }
    }
};
struct EpiPP {
    static constexpr bool PERM = true, AFTER_DRAIN = false;
    bf16_t* O;
    __device__ __forceinline__ void operator()(const f32x4 (&acc)[2][2][4][2], const Unit& u, int wr, int wc, int fr, int fq) const {
        const int row0 = u.pm * BM + wr * 64 + fr, col0 = u.pn * BM + wc * 32 + 8 * fq;
#pragma unroll
        for (int ai = 0; ai < 2; ++ai)
#pragma unroll
            for (int m = 0; m < 4; ++m) { bf16_t* rowp = O + (size_t)(row0 + ai * HALF + m * 16) * DM + col0;
#pragma unroll
                for (int bj = 0; bj < 2; ++bj) { const f32x4 v0 = acc[ai][bj][m][0], v1 = acc[ai][bj][m][1];
                    u32x4 w; w.x = cvt_pk_bf16(v0[0], v0[1]); w.y = cvt_pk_bf16(v0[2], v0[3]); w.z = cvt_pk_bf16(v1[0], v1[1]); w.w = cvt_pk_bf16(v1[2], v1[3]);
                    *(u32x4*)(rowp + bj * HALF) = w; } }
    }
};
struct EpiPle {
    static constexpr bool PERM = true, AFTER_DRAIN = false;
    const bf16_t* hin; bf16_t* hout; const bf16_t* pp; const float* bias; const float* rowss; float* rowss_out;
    __device__ __forceinline__ void operator()(const f32x4 (&acc)[2][2][4][2], const Unit& u, int wr, int wc, int fr, int fq) const {
        const int row0 = u.pm * BM + wr * 64 + fr, col0 = u.pn * BM + wc * 32 + 8 * fq;
        f32x4 bv[2][2];
#pragma unroll
        for (int bj = 0; bj < 2; ++bj) { bv[bj][0] = *(const f32x4*)(bias + col0 + bj * HALF); bv[bj][1] = *(const f32x4*)(bias + col0 + bj * HALF + 4); }
        float rsv[2][4];
#pragma unroll
        for (int ai = 0; ai < 2; ++ai)
#pragma unroll
            for (int m = 0; m < 4; ++m) rsv[ai][m] = rowss[row0 + ai * HALF + m * 16];
#pragma unroll
        for (int ai = 0; ai < 2; ++ai)
#pragma unroll
            for (int mp = 0; mp < 2; ++mp) {
                u32x4 hr[2][2], pr[2][2];
#pragma unroll
                for (int mm = 0; mm < 2; ++mm)
#pragma unroll
                    for (int bj = 0; bj < 2; ++bj) { const size_t off = (size_t)(row0 + ai * HALF + (2 * mp + mm) * 16) * DM + col0 + bj * HALF; hr[mm][bj] = *(const u32x4*)(hin + off); pr[mm][bj] = *(const u32x4*)(pp + off); }
#pragma unroll
                for (int mm = 0; mm < 2; ++mm) { const int m = 2 * mp + mm;
                    const int row = row0 + ai * HALF + m * 16; const float rs = rsqrtf(rsv[ai][m] * (1.f / 1024.f) + EPSN); float ss = 0.f;
#pragma unroll
                    for (int bj = 0; bj < 2; ++bj) { const size_t off = (size_t)row * DM + col0 + bj * HALF;
                        float hv[8], pv[8]; unpack8(hr[mm][bj], hv); unpack8(pr[mm][bj], pv);
#pragma unroll
                        for (int j = 0; j < 4; ++j) { hv[j] += sigmoidf_(acc[ai][bj][m][0][j] * rs + bv[bj][0][j]) * pv[j]; hv[4 + j] += sigmoidf_(acc[ai][bj][m][1][j] * rs + bv[bj][1][j]) * pv[4 + j]; }
                        u32x4 w; w.x = cvt_pk_bf16(hv[0], hv[1]); w.y = cvt_pk_bf16(hv[2], hv[3]); w.z = cvt_pk_bf16(hv[4], hv[5]); w.w = cvt_pk_bf16(hv[6], hv[7]);
                        *(u32x4*)(hout + off) = w;
#pragma unroll
                        for (int j = 0; j < 8; ++j) ss += hv[j] * hv[j]; }
                    ss += __shfl_xor(ss, 16); ss += __shfl_xor(ss, 32);
                    if (fq == 0) unsafeAtomicAdd(rowss_out + row, ss);
                }
            }
    }
};

struct InTab {
    const __attribute__((address_space(4))) char* kp;
    DEV const float* operator[](int i) const { return (const float*)(*(const __attribute__((address_space(1))) float* const __attribute__((address_space(4)))*)(kp + 8 * i)); }
};
struct Ctx {
    InTab in; float* out; unsigned char* ws;
    lptr L; int tid, lane, wave, G, bid;
    DEV float* rs(int i) const { return (float*)(ws + WS_RS) + (size_t)i * MTOK; }
    DEV bf16_t* bfp(size_t off) const { return (bf16_t*)(ws + off); }
};

DEV void p0_item(const Ctx& c, const float* W0, const float* W1, int K, int N, int mode, const float* gain, const float* g1, const float* g2, bf16_t* dst, int item, int nblk) {
    LAS float* scr = (LAS float*)(c.L + c.wave * 16384);
    const int lane = c.lane, kb = item / nblk, nb = item % nblk, k0 = 64 * kb, n0 = 32 * nb;
    const int r = n0 + (lane & 31); int sc = r; const float* W = W0;
    if (mode == 1) { if (r < 1280) sc = r; else if (r < 2944) sc = r + 6; else if (r < 2950) sc = 1280 + (r - 2944); else if (r < 2956) sc = r; else sc = -1; }
    else if (mode == 2) { const int t = r >> 8, w = r & 255; sc = 128 * t + (w & 127); W = (w < 128) ? W0 : W1; }
    const int scc = sc < 0 ? 0 : sc; const float keep = sc < 0 ? 0.f : 1.f;
    float wv[32], gv[32];
#pragma unroll
    for (int i = 0; i < 32; ++i) { const int k = k0 + 2 * i + (lane >> 5); wv[i] = W[(size_t)k * N + scc];
        if (gain) { const float* gp = g1 ? ((k < 384) ? gain + k : (k < 640 ? g1 + (k - 384) : g2 + (k - 640))) : gain + k; gv[i] = *gp; } else gv[i] = 1.f; }
#pragma unroll
    for (int i = 0; i < 32; ++i) scr[(2 * i + (lane >> 5)) * 33 + (lane & 31)] = wv[i] * gv[i] * keep;
    asm volatile("s_waitcnt lgkmcnt(0)" ::: "memory");
    const int cc = lane & 7;
#pragma unroll
    for (int j = 0; j < 4; ++j) { const int n = (lane >> 3) + 8 * j; const LAS float* s = scr + (8 * cc) * 33 + n;
        u32x4 o; o.x = pk2(s[0 * 33], s[1 * 33]); o.y = pk2(s[2 * 33], s[3 * 33]); o.z = pk2(s[4 * 33], s[5 * 33]); o.w = pk2(s[6 * 33], s[7 * 33]);
        *(u32x4*)(dst + (size_t)(n0 + n) * K + k0 + 8 * cc) = o; }
    asm volatile("s_waitcnt lgkmcnt(0)" ::: "memory");
}
constexpr int P0_I_IN = 16 * 96, P0_I_OUT = 16 * 32, P0_I_GU = 16 * 176, P0_I_DN = 44 * 32, P0_I_PG = 16 * 32, P0_I_PP = 4 * 32, P0_I_L = P0_I_IN + P0_I_OUT + P0_I_GU + P0_I_DN + P0_I_PG + P0_I_PP;
DEV void p0_weight_item(const Ctx& c, int l, int r) {
    if (r < P0_I_IN) { p0_item(c, c.in[3] + (size_t)l * 1024 * 2956, nullptr, 1024, 2956, 1, c.in[2] + l * 1024, nullptr, nullptr, c.bfp(WS_WIN) + (size_t)l * NPROJ * 1024, r, 96); return; } r -= P0_I_IN;
    if (r < P0_I_OUT) { p0_item(c, c.in[20] + (size_t)l * 1024 * 1024, nullptr, 1024, 1024, 0, c.in[9] + l * 384, c.in[17] + l * 256, c.in[19] + l * 384, c.bfp(WS_WOUT) + (size_t)l * 1024 * 1024, r, 32); return; } r -= P0_I_OUT;
    if (r < P0_I_GU) { p0_item(c, c.in[22] + (size_t)l * 1024 * DFF, c.in[23] + (size_t)l * 1024 * DFF, 1024, DFF, 2, c.in[21] + l * 1024, nullptr, nullptr, c.bfp(WS_WGU) + (size_t)l * 5632 * 1024, r, 176); return; } r -= P0_I_GU;
    if (r < P0_I_DN) { p0_item(c, c.in[24] + (size_t)l * DFF * 1024, nullptr, DFF, 1024, 0, nullptr, nullptr, nullptr, c.bfp(WS_WDN) + (size_t)l * 1024 * DFF, r, 32); return; } r -= P0_I_DN;
    if (r < P0_I_PG) { p0_item(c, c.in[26] + (size_t)l * 1024 * 1024, nullptr, 1024, 1024, 0, c.in[25] + l * 1024, nullptr, nullptr, c.bfp(WS_WPG) + (size_t)l * 1024 * 1024, r, 32); return; } r -= P0_I_PG;
    p0_item(c, c.in[28] + (size_t)l * PLE * 1024, nullptr, PLE, 1024, 0, nullptr, nullptr, nullptr, c.bfp(WS_WPP) + (size_t)l * 1024 * PLE, r, 32);
}
DEV void p0_p_items(const Ctx& c, int l, int base) {
    const f32x4* p4 = (const f32x4*)c.in[1] + (size_t)l * (MTOK * PLE / 4); u32x4* o = (u32x4*)c.bfp(WS_PB) + (size_t)l * (MTOK * PLE / 8);
    f32x4 a[8], bq[8];
#pragma unroll
    for (int q = 0; q < 8; ++q) { const size_t i = (size_t)base + q * 512 + c.tid; a[q] = __builtin_nontemporal_load(p4 + 2 * i); bq[q] = __builtin_nontemporal_load(p4 + 2 * i + 1); }
#pragma unroll
    for (int q = 0; q < 8; ++q) { u32x4 w; w.x = pk2(a[q][0], a[q][1]); w.y = pk2(a[q][2], a[q][3]); w.z = pk2(bq[q][0], bq[q][1]); w.w = pk2(bq[q][2], bq[q][3]); o[(size_t)base + q * 512 + c.tid] = w; }
}
DEV void p0_prologue(const Ctx& c) {
    const int gw = c.bid * 8 + c.wave, NGW = c.G * 8;
    const int gt = c.bid * 512 + c.tid, NGT = c.G * 512;
    { f32x4* z = (f32x4*)c.rs(1); const int n4 = (RS_COUNT - 1) * MTOK / 4; for (int i = gt; i < n4; i += NGT) z[i] = (f32x4){0.f, 0.f, 0.f, 0.f};
      unsigned* ctl = (unsigned*)(c.ws + WS_CTL); if (gt < 4096) ctl[gt] = 0u; }
    for (int it = gw; it < P0_I_L; it += NGW) p0_weight_item(c, 0, it);
    { float* rs0 = c.rs(RS_IN0); bf16_t* hb = c.bfp(WS_HBA);
      for (int m0 = gw; m0 < MTOK; m0 += 4 * NGW) {
          f32x4 v[4][4];
#pragma unroll
          for (int q = 0; q < 4; ++q) { const f32x4* xr = (const f32x4*)(c.in[0] + (size_t)(m0 + q * NGW) * DM) + c.lane;
#pragma unroll
              for (int j = 0; j < 4; ++j) v[q][j] = __builtin_nontemporal_load(xr + 64 * j); }
#pragma unroll
          for (int q = 0; q < 4; ++q) { const int m = m0 + q * NGW; float s = 0.f; u32x2* o = (u32x2*)(hb + (size_t)m * DM) + c.lane;
#pragma unroll
              for (int j = 0; j < 4; ++j) { const f32x4 t = v[q][j]; s += (t[0] * t[0] + t[1] * t[1]) + (t[2] * t[2] + t[3] * t[3]); u32x2 w; w.x = pk2(t[0], t[1]); w.y = pk2(t[2], t[3]); o[64 * j] = w; }
              s = wave_sum64(s); if (c.lane == 0) rs0[m] = s; } } }
    for (int base = c.bid * 4096; base < MTOK * PLE / 8; base += c.G * 4096) p0_p_items(c, 0, base);
}

DEV bf16x8 vtr8(lptr p0, lptr p1) {
    const v4i16_t lo = __builtin_amdgcn_ds_read_tr16_b64_v4i16((LAS v4i16_t*)p0), hi = __builtin_amdgcn_ds_read_tr16_b64_v4i16((LAS v4i16_t*)p1);
    return (bf16x8){lo[0], lo[1], lo[2], lo[3], hi[0], hi[1], hi[2], hi[3]};
}
DEV bf16x8 trfrag(lptr img, int pitch, int k0, int c0, int r16, int g4) { const lptr p = img + (k0 + 8 * g4 + (r16 >> 2)) * pitch + (c0 + 4 * (r16 & 3)) * 2; return vtr8(p, p + 4 * pitch); }
constexpr int SP = 272, XP = 144;
constexpr int O_XS = 0, O_BM = O_XS + 128 * XP, O_BW = O_BM + 128 * SP, O_CM = O_BW + 128 * SP, O_PREV = O_CM + 128 * SP, O_FL = O_PREV + 64 * SP, O_DUMMY = O_FL + 2048, O_SEQ = O_DUMMY + 4096;
static_assert(O_SEQ + 16384 <= LDS_BYTES - 64, "ssd lds");
DEV void ssd_unit(const Ctx& c, int layer, int b, int h) {
    const lptr L = c.L; const int tid = c.tid, lane = c.lane, w = c.wave, r16 = lane & 15, g4 = lane >> 4;
    const int grp = h / 3;
    const bf16_t* proj = c.bfp(WS_PROJ); const float* side = (const float*)(c.ws + WS_SIDE); bf16_t* ybuf = c.bfp(WS_Y);
    float* rss = c.rs(RS_SSD + layer);
    const float* cw = c.in[4] + (size_t)layer * 4 * 896; const float* cb = c.in[5] + (size_t)layer * 896;
    const float Aneg = -__expf(c.in[7][layer * 6 + h]), dtb = c.in[6][layer * 6 + h], Dh = c.in[8][layer * 6 + h];
    LAS float* dt_all = (LAS float*)(L + O_SEQ); LAS float* acs_all = dt_all + SEQ;
    f32x4 S[4];
#pragma unroll
    for (int i = 0; i < 4; ++i) S[i] = (f32x4){0.f, 0.f, 0.f, 0.f};
    const int cg4 = tid % 80, t0 = (tid / 80) * 22; const bool conv_on = tid < 480;
    const int cc = cg4 * 4;
    const int col = (cc < 64) ? (C_X + h * 64 + cc) : (cc < 192 ? (C_B + grp * 128 + (cc - 64)) : (C_C + grp * 128 + (cc - 192)));
    const int cidx = (cc < 64) ? (h * 64 + cc) : (cc < 192 ? (384 + grp * 128 + (cc - 64)) : (640 + grp * 128 + (cc - 192)));
    const f32x4 wt0 = *(const f32x4*)(cw + cidx), wt1 = *(const f32x4*)(cw + 896 + cidx), wt2 = *(const f32x4*)(cw + 2 * 896 + cidx), wt3 = *(const f32x4*)(cw + 3 * 896 + cidx), wbs = *(const f32x4*)(cb + cidx);
    const bool isB = (cc >= 64) && (cc < 192);
    const int dst0 = (cc < 64) ? (O_XS + cc * 2) : (cc < 192 ? (O_BM + (cc - 64) * 2) : (O_CM + (cc - 192) * 2)), pitch0 = (cc < 64) ? XP : SP;
    const int dst1 = O_BW + (cc - 64) * 2, dummy = O_DUMMY + tid * 8;
    { float d[4], run = 0.f, pre[4];
#pragma unroll
      for (int i = 0; i < 4; ++i) d[i] = side[(size_t)(b * SEQ + 4 * tid + i) * 16 + h];
#pragma unroll
      for (int i = 0; i < 4; ++i) { d[i] = softplusf_(d[i] + dtb); run += Aneg * d[i]; pre[i] = run; }
      float sc = run;
#pragma unroll
      for (int o = 1; o < 32; o <<= 1) { const float t = __shfl_up(sc, o, 32); if ((lane & 31) >= o) sc += t; }
      const float base = sc - run;
      *(LAS f32x4*)(dt_all + 4 * tid) = (f32x4){d[0], d[1], d[2], d[3]}; *(LAS f32x4*)(acs_all + 4 * tid) = (f32x4){base + pre[0], base + pre[1], base + pre[2], base + pre[3]}; }
    WGBAR();
    for (int ch = 0; ch < 16; ++ch) {
        const int row0 = b * SEQ + ch * 128;
        const LAS float* dt_s = dt_all + ch * 128; const LAS float* acs_s = acs_all + ch * 128;
#pragma unroll
        for (int i = 0; i < 4; ++i)
#pragma unroll
            for (int r = 0; r < 4; ++r) { const int p = 16 * (w & 3) + 4 * g4 + r, n = 16 * (4 * (w >> 2) + i) + r16; *(LAS unsigned short*)(L + O_PREV + p * SP + n * 2) = (unsigned short)f2bf(S[i][r]); }
        unsigned short zv[4][4];
#pragma unroll
        for (int pt = 0; pt < 4; ++pt)
#pragma unroll
            for (int r = 0; r < 4; ++r) zv[pt][r] = proj[(size_t)(row0 + 16 * w + 4 * g4 + r) * NPROJ + C_Z + h * 64 + 16 * pt + r16];
        WGBAR();
        const float total = acs_s[127];
        if (conv_on) {
            const int sp0 = ch * 128 + t0;
            const bf16_t* src = proj + (size_t)(b * SEQ + sp0) * NPROJ + col;
            const u32x2 zz = (u32x2){0u, 0u};
            const int hb_ = (sp0 >= 3) ? 1 : 0;
            u32x2 r0 = *(const u32x2*)(src - (ptrdiff_t)(3 * hb_) * NPROJ), r1 = *(const u32x2*)(src - (ptrdiff_t)(2 * hb_) * NPROJ), r2 = *(const u32x2*)(src - (ptrdiff_t)hb_ * NPROJ);
            if (!hb_) { r0 = zz; r1 = zz; r2 = zz; }
            f32x4 x0 = (f32x4){bflo(r0.x), bfhi(r0.x), bflo(r0.y), bfhi(r0.y)}, x1 = (f32x4){bflo(r1.x), bfhi(r1.x), bflo(r1.y), bfhi(r1.y)}, x2 = (f32x4){bflo(r2.x), bfhi(r2.x), bflo(r2.y), bfhi(r2.y)};
#pragma unroll 1
            for (int half = 0; half < 2; ++half) {
                u32x2 rr[11];
#pragma unroll
                for (int i = 0; i < 11; ++i) { const int ii = half * 11 + i; const int li = (t0 + ii < 128) ? ii : (127 - t0); rr[i] = *(const u32x2*)(src + (size_t)li * NPROJ); }
                float wlv[11];
#pragma unroll
                for (int i = 0; i < 11; ++i) { const int l_ = t0 + half * 11 + i; const int lw_ = (l_ < 128) ? l_ : 127; wlv[i] = dt_s[lw_] * __expf(total - acs_s[lw_]); }
#pragma unroll
                for (int i = 0; i < 11; ++i) {
                    const int l = t0 + half * 11 + i; const bool valid = l < 128;
                    const u32x2 r3 = rr[i];
                    const f32x4 x3 = (f32x4){bflo(r3.x), bfhi(r3.x), bflo(r3.y), bfhi(r3.y)};
                    const f32x4 a = wbs + wt0 * x0 + wt1 * x1 + wt2 * x2 + wt3 * x3;
                    const f32x4 v = (f32x4){siluf_(a[0]), siluf_(a[1]), siluf_(a[2]), siluf_(a[3])};
                    const float wl = wlv[i];
                    u32x2 o; o.x = pk2(v[0], v[1]); o.y = pk2(v[2], v[3]);
                    u32x2 o2; o2.x = pk2(v[0] * wl, v[1] * wl); o2.y = pk2(v[2] * wl, v[3] * wl);
                    *(LAS u32x2*)(L + (valid ? dst0 + l * pitch0 : dummy)) = o;
                    *(LAS u32x2*)(L + ((valid && isB) ? dst1 + l * SP : dummy)) = o2;
                    x0 = x1; x1 = x2; x2 = x3;
                }
            }
        }
        WGBAR();
        bf16x8 ca[4];
#pragma unroll
        for (int ks = 0; ks < 4; ++ks) ca[ks] = ldsA(L + O_CM + (16 * w + r16) * SP + (32 * ks + 8 * g4) * 2);
        f32x4 Gt[8];
#pragma unroll
        for (int ct = 0; ct < 8; ++ct) { Gt[ct] = (f32x4){0.f, 0.f, 0.f, 0.f};
            if (ct <= w) {
#pragma unroll
                for (int ks = 0; ks < 4; ++ks) Gt[ct] = MFMA16(ca[ks], ldsA(L + O_BM + (16 * ct + r16) * SP + (32 * ks + 8 * g4) * 2), Gt[ct]); } }
        WGBAR();
        { const f32x4 al = *(const LAS f32x4*)(acs_s + 16 * w + 4 * g4);
          float asv[8], dsv[8];
#pragma unroll
          for (int ct = 0; ct < 8; ++ct) { asv[ct] = acs_s[16 * ct + r16]; dsv[ct] = dt_s[16 * ct + r16]; }
#pragma unroll
          for (int ct = 0; ct < 8; ++ct) { const int s = 16 * ct + r16; const float as = asv[ct], ds = dsv[ct];
#pragma unroll
              for (int r = 0; r < 4; ++r) { const int l = 16 * w + 4 * g4 + r; const float v = (s <= l) ? Gt[ct][r] * __expf(al[r] - as) * ds : 0.f;
                  *(LAS unsigned short*)(L + O_BM + l * SP + s * 2) = (unsigned short)f2bf(v); } } }
        WGBAR();
        if (ch < 15 && conv_on) { const bf16_t* nsrc = proj + (size_t)(b * SEQ + (ch + 1) * 128 + t0) * NPROJ + col;
#pragma unroll
            for (int r = -3; r < 22; ++r) { const int li = (t0 + r < 128) ? r : (127 - t0); __builtin_amdgcn_global_load_lds((const unsigned*)(nsrc + (ptrdiff_t)li * NPROJ), (LAS unsigned*)(L + O_DUMMY + w * 256), 4, 0, 0); } }
        f32x4 Y[4];
#pragma unroll
        for (int pt = 0; pt < 4; ++pt) { Y[pt] = (f32x4){0.f, 0.f, 0.f, 0.f};
#pragma unroll
            for (int ks = 0; ks < 4; ++ks) Y[pt] = MFMA16(ca[ks], ldsA(L + O_PREV + (16 * pt + r16) * SP + (32 * ks + 8 * g4) * 2), Y[pt]); }
        { const f32x4 al = *(const LAS f32x4*)(acs_s + 16 * w + 4 * g4);
#pragma unroll
          for (int r = 0; r < 4; ++r) { const float e = __expf(al[r]);
#pragma unroll
              for (int pt = 0; pt < 4; ++pt) Y[pt][r] *= e; } }
#pragma unroll
        for (int ks = 0; ks < 4; ++ks) if (ks <= (w >> 1)) { const bf16x8 sa = ldsA(L + O_BM + (16 * w + r16) * SP + (32 * ks + 8 * g4) * 2);
#pragma unroll
            for (int pt = 0; pt < 4; ++pt) Y[pt] = MFMA16(sa, trfrag(L + O_XS, XP, 32 * ks, 16 * pt, r16, g4), Y[pt]); }
        { float ss[4] = {0.f, 0.f, 0.f, 0.f};
#pragma unroll
          for (int pt = 0; pt < 4; ++pt) { const int p = 16 * pt + r16;
#pragma unroll
              for (int r = 0; r < 4; ++r) { const int l = 16 * w + 4 * g4 + r; const size_t row = (size_t)(row0 + l);
                  const float xs = bf2f(*(const LAS unsigned short*)(L + O_XS + l * XP + p * 2));
                  const float z = bf2f(zv[pt][r]); const float yo = (Y[pt][r] + Dh * xs) * siluf_(z);
                  ybuf[row * DM + h * 64 + p] = (bf16_t)f2bf(yo); ss[r] += yo * yo; } }
#pragma unroll
          for (int r = 0; r < 4; ++r) { float s = ss[r]; s += __shfl_xor(s, 1); s += __shfl_xor(s, 2); s += __shfl_xor(s, 4); s += __shfl_xor(s, 8);
              if (r16 == 0) unsafeAtomicAdd(rss + row0 + 16 * w + 4 * g4 + r, s); } }
        { const float dec = __expf(total);
#pragma unroll
          for (int i = 0; i < 4; ++i) S[i] *= dec;
#pragma unroll
          for (int ks = 0; ks < 4; ++ks) { const bf16x8 xa = trfrag(L + O_XS, XP, 32 * ks, 16 * (w & 3), r16, g4);
#pragma unroll
              for (int i = 0; i < 4; ++i) S[i] = MFMA16(xa, trfrag(L + O_BW, SP, 32 * ks, 16 * (4 * (w >> 2) + i), r16, g4), S[i]); } }
        WGBAR();
    }
}

constexpr int LP = 144;
constexpr int O_LX = 0, O_WA = O_LX + 128 * LP, O_WX = O_WA + 64 * LP, O_XF = O_WX + 64 * LP, O_AS = O_XF + 32768, O_US = O_AS + 32768, O_SEG = O_US + 32768, O_CW = O_SEG + 4096, O_GT = O_CW + 1280;
static_assert(O_GT + 16384 <= LDS_BYTES - 64, "lru lds");
DEV void lru_unit(const Ctx& c, int layer, int b, int g) {
    const lptr L = c.L; const int tid = c.tid, lane = c.lane, w = c.wave, r16 = lane & 15, g4 = lane >> 4;
    const bf16_t* proj = c.bfp(WS_PROJ); bf16_t* ybuf = c.bfp(WS_Y); float* rss = c.rs(RS_LRU + layer);
    const float* cw = c.in[10] + (size_t)layer * 4 * 256; const float* cb = c.in[11] + (size_t)layer * 256;
    const float* wa = c.in[12] + ((size_t)layer * 4 + g) * 4096; const float* wx = c.in[14] + ((size_t)layer * 4 + g) * 4096;
    LAS float* xf = (LAS float*)(L + O_XF); LAS float* a_s = (LAS float*)(L + O_AS); LAS float* u_s = (LAS float*)(L + O_US);
    LAS float* segH = (LAS float*)(L + O_SEG); LAS float* segP = segH + 512;
    for (int e = tid; e < 4096; e += 512) { const int i = e >> 6, j = e & 63;
        *(LAS unsigned short*)(L + O_WA + j * LP + i * 2) = (unsigned short)f2bf(wa[e]); *(LAS unsigned short*)(L + O_WX + j * LP + i * 2) = (unsigned short)f2bf(wx[e]); }
    float ba[4], bx[4], spl[4];
#pragma unroll
    for (int jt = 0; jt < 4; ++jt) { const int ch = 64 * g + 16 * jt + r16; ba[jt] = c.in[13][layer * 256 + ch]; bx[jt] = c.in[15][layer * 256 + ch]; spl[jt] = softplusf_(-c.in[16][layer * 256 + ch]); }
    WGBAR();
    float carry = 0.f;
    const int cgi = tid & 7, t0 = (tid >> 3) * 2;
    LAS float* cwl = (LAS float*)(L + O_CW);
    if (tid < 256) cwl[tid] = cw[(tid >> 6) * 256 + 64 * g + (tid & 63)]; else if (tid < 320) cwl[tid] = cb[64 * g + (tid - 256)];
    u32x4 G0, G1;
    u32x4 R0, R1, R2, R3, R4;
    { const bf16_t* src = proj + (size_t)(b * SEQ + t0) * NPROJ + C_LX + 64 * g + cgi * 8; const u32x4 zz = (u32x4){0u, 0u, 0u, 0u};
      R0 = t0 >= 3 ? *(const u32x4*)(src - 3 * NPROJ) : zz; R1 = t0 >= 2 ? *(const u32x4*)(src - 2 * NPROJ) : zz; R2 = t0 >= 1 ? *(const u32x4*)(src - 1 * NPROJ) : zz; R3 = *(const u32x4*)(src); R4 = *(const u32x4*)(src + NPROJ);
      G0 = *(const u32x4*)(src + (C_LG - C_LX)); G1 = *(const u32x4*)(src + NPROJ + (C_LG - C_LX)); }
    for (int ch = 0; ch < 16; ++ch) {
        const int row0 = b * SEQ + ch * 128;
        { float x0[8], x1[8], x2[8], x3[8], x4[8];
          unpack8(R0, x0); unpack8(R1, x1); unpack8(R2, x2); unpack8(R3, x3); unpack8(R4, x4);
          *(LAS u32x4*)(L + O_GT + t0 * 128 + cgi * 16) = G0; *(LAS u32x4*)(L + O_GT + (t0 + 1) * 128 + cgi * 16) = G1;
          if (ch < 15) { const bf16_t* src = proj + (size_t)(row0 + 128 + t0) * NPROJ + C_LX + 64 * g + cgi * 8;
              R0 = *(const u32x4*)(src - 3 * NPROJ); R1 = *(const u32x4*)(src - 2 * NPROJ); R2 = *(const u32x4*)(src - 1 * NPROJ); R3 = *(const u32x4*)(src); R4 = *(const u32x4*)(src + NPROJ);
              G0 = *(const u32x4*)(src + (C_LG - C_LX)); G1 = *(const u32x4*)(src + NPROJ + (C_LG - C_LX)); }
          float v0[8], v1[8];
#pragma unroll
          for (int j = 0; j < 8; ++j) { const float bsj = cwl[256 + cgi * 8 + j], w0 = cwl[cgi * 8 + j], w1 = cwl[64 + cgi * 8 + j], w2 = cwl[128 + cgi * 8 + j], w3 = cwl[192 + cgi * 8 + j];
              v0[j] = bsj + w0 * x0[j] + w1 * x1[j] + w2 * x2[j] + w3 * x3[j]; v1[j] = bsj + w0 * x1[j] + w1 * x2[j] + w2 * x3[j] + w3 * x4[j]; }
          u32x4 o; o.x = pk2(v0[0], v0[1]); o.y = pk2(v0[2], v0[3]); o.z = pk2(v0[4], v0[5]); o.w = pk2(v0[6], v0[7]); *(LAS u32x4*)(L + O_LX + t0 * LP + cgi * 16) = o;
          o.x = pk2(v1[0], v1[1]); o.y = pk2(v1[2], v1[3]); o.z = pk2(v1[4], v1[5]); o.w = pk2(v1[6], v1[7]); *(LAS u32x4*)(L + O_LX + (t0 + 1) * LP + cgi * 16) = o;
          *(LAS f32x4*)(xf + t0 * 64 + cgi * 8) = (f32x4){v0[0], v0[1], v0[2], v0[3]}; *(LAS f32x4*)(xf + t0 * 64 + cgi * 8 + 4) = (f32x4){v0[4], v0[5], v0[6], v0[7]};
          *(LAS f32x4*)(xf + (t0 + 1) * 64 + cgi * 8) = (f32x4){v1[0], v1[1], v1[2], v1[3]}; *(LAS f32x4*)(xf + (t0 + 1) * 64 + cgi * 8 + 4) = (f32x4){v1[4], v1[5], v1[6], v1[7]}; }
        WGBAR();
        { bf16x8 xa[2];
#pragma unroll
          for (int ks = 0; ks < 2; ++ks) xa[ks] = ldsA(L + O_LX + (16 * w + r16) * LP + (32 * ks + 8 * g4) * 2);
          float xv[4][4];
#pragma unroll
          for (int jt = 0; jt < 4; ++jt)
#pragma unroll
              for (int r = 0; r < 4; ++r) xv[jt][r] = xf[(16 * w + 4 * g4 + r) * 64 + 16 * jt + r16];
#pragma unroll
          for (int jt = 0; jt < 4; ++jt) { f32x4 R = (f32x4){0.f, 0.f, 0.f, 0.f}, I = R;
#pragma unroll
              for (int ks = 0; ks < 2; ++ks) { R = MFMA16(xa[ks], ldsA(L + O_WA + (16 * jt + r16) * LP + (32 * ks + 8 * g4) * 2), R); I = MFMA16(xa[ks], ldsA(L + O_WX + (16 * jt + r16) * LP + (32 * ks + 8 * g4) * 2), I); }
#pragma unroll
              for (int r = 0; r < 4; ++r) { const int t = 16 * w + 4 * g4 + r, j = 16 * jt + r16;
                  const float rg = sigmoidf_(R[r] + ba[jt]), ig = sigmoidf_(I[r] + bx[jt]); const float la = -8.f * rg * spl[jt];
                  const float a = __expf(la), mult = __builtin_amdgcn_sqrtf(fmaxf(1.f - a * a, 0.f));
                  a_s[t * 64 + j] = a; u_s[t * 64 + j] = mult * ig * xv[jt][r]; } } }
        WGBAR();
        { float hh = 0.f, pp = 1.f; float av[16], uv[16];
#pragma unroll
          for (int i = 0; i < 16; ++i) { av[i] = a_s[(16 * w + i) * 64 + lane]; uv[i] = u_s[(16 * w + i) * 64 + lane]; }
#pragma unroll
          for (int i = 0; i < 16; ++i) { hh = av[i] * hh + uv[i]; pp *= av[i]; uv[i] = hh; av[i] = pp; }
#pragma unroll
          for (int i = 0; i < 16; ++i) { u_s[(16 * w + i) * 64 + lane] = uv[i]; a_s[(16 * w + i) * 64 + lane] = av[i]; }
          segH[w * 64 + lane] = hh; segP[w * 64 + lane] = pp; }
        WGBAR();
        { float cin = carry, call = carry;
#pragma unroll
          for (int q = 0; q < 8; ++q) { const float sh = segH[q * 64 + lane], sp = segP[q * 64 + lane]; call = sp * call + sh; if (q < w) cin = call; }
          carry = call;
#pragma unroll 2
          for (int i = 0; i < 16; ++i) { const int t = 16 * w + i; const size_t row = (size_t)(row0 + t);
              const float hv = u_s[t * 64 + lane] + a_s[t * 64 + lane] * cin;
              const float gt = bf2f(*(const LAS unsigned short*)(L + O_GT + t * 128 + lane * 2)); const float yo = hv * gelu_tanhf_(gt);
              ybuf[row * DM + 384 + 64 * g + lane] = (bf16_t)f2bf(yo);
              const float s = wave_sum64(yo * yo); if (lane == 0) unsafeAtomicAdd(rss + row, s); } }
        WGBAR();
    }
}

constexpr int KP = 144;
constexpr int O_NB = 0, O_KV = 8192, KVB = 64 * KP  , O_RED = O_KV + 8 * KVB;
static_assert(O_RED + 256 <= LDS_BYTES - 64, "fox lds");
DEV void fox_tile(const lptr Kb, const lptr Vb, const LAS float* nb, const bf16x8 (&qf)[2][2], f32x4 (&o)[4][2], float (&mrun)[2], f32x4 (&lacc)[2], int kv0, int q0, int r16, int g4) {
        if (kv0 <= q0 + 31) {
        bf16x8 kf[4][2]; f32x4 bias[4];
#pragma unroll
        for (int kt = 0; kt < 4; ++kt) {
#pragma unroll
            for (int ks = 0; ks < 2; ++ks) kf[kt][ks] = ldsA(Kb + (16 * kt + r16) * KP + (32 * ks + 8 * g4) * 2);
            bias[kt] = *(const LAS f32x4*)(nb + kv0 + 16 * kt + 4 * g4); }
        f32x4 s[4][2];
        __builtin_amdgcn_s_setprio(1);
#pragma unroll
        for (int kt = 0; kt < 4; ++kt) { s[kt][0] = bias[kt]; s[kt][1] = bias[kt];
#pragma unroll
            for (int ks = 0; ks < 2; ++ks) { s[kt][0] = MFMA16(kf[kt][ks], qf[0][ks], s[kt][0]); s[kt][1] = MFMA16(kf[kt][ks], qf[1][ks], s[kt][1]); } }
        __builtin_amdgcn_s_setprio(0);
        bf16x8 vf[2][4];
#pragma unroll
        for (int k2 = 0; k2 < 2; ++k2)
#pragma unroll
            for (int dt = 0; dt < 4; ++dt) { const lptr va = Vb + (32 * k2 + 4 * g4 + (r16 >> 2)) * KP + (16 * dt + 4 * (r16 & 3)) * 2; vf[k2][dt] = vtr8(va, va + 16 * KP); }
        __builtin_amdgcn_sched_barrier(0);
        const bool diag = (kv0 + 63 > q0);
        float mnew[2] = {mrun[0], mrun[1]};
        if (diag) {
#pragma unroll
            for (int kt = 0; kt < 4; ++kt)
#pragma unroll
                for (int qt = 0; qt < 2; ++qt)
#pragma unroll
                    for (int r = 0; r < 4; ++r) { const int kv = kv0 + 16 * kt + 4 * g4 + r, q = q0 + 16 * qt + r16; if (kv > q) s[kt][qt][r] = -INFINITY; }
        }
#pragma unroll
        for (int kt = 0; kt < 4; ++kt)
#pragma unroll
            for (int qt = 0; qt < 2; ++qt)
#pragma unroll
                for (int r = 0; r < 4; ++r) mnew[qt] = fmaxf(mnew[qt], s[kt][qt][r]);
        float alpha[2];
#pragma unroll
        for (int qt = 0; qt < 2; ++qt) { float m = mnew[qt]; m = fmaxf(m, __shfl_xor(m, 16));
            { const auto rr = __builtin_amdgcn_permlane32_swap(__float_as_uint(m), __float_as_uint(m), false, false); m = fmaxf(__uint_as_float(rr[0]), __uint_as_float(rr[1])); }
            mnew[qt] = m; alpha[qt] = ex2_(mrun[qt] - m); }
        const bool grew = __any((mnew[0] > mrun[0]) || (mnew[1] > mrun[1]));
        mrun[0] = mnew[0]; mrun[1] = mnew[1];
#pragma unroll
        for (int kt = 0; kt < 4; ++kt)
#pragma unroll
            for (int qt = 0; qt < 2; ++qt)
#pragma unroll
                for (int r = 0; r < 4; ++r) s[kt][qt][r] = ex2_(s[kt][qt][r] - mnew[qt]);
        if (grew) {
#pragma unroll
            for (int qt = 0; qt < 2; ++qt) { lacc[qt] *= alpha[qt];
#pragma unroll
                for (int dt = 0; dt < 4; ++dt) o[dt][qt] *= alpha[qt]; } }
        const bf16x8 ones = (bf16x8){0x3f80, 0x3f80, 0x3f80, 0x3f80, 0x3f80, 0x3f80, 0x3f80, 0x3f80};
#pragma unroll
        for (int k2 = 0; k2 < 2; ++k2) {
            bf16x8 pb[2];
#pragma unroll
            for (int qt = 0; qt < 2; ++qt) { const f32x4 a = s[2 * k2][qt], bq = s[2 * k2 + 1][qt];
                const u32x4 wv = (u32x4){pk2(a[0], a[1]), pk2(a[2], a[3]), pk2(bq[0], bq[1]), pk2(bq[2], bq[3])}; pb[qt] = __builtin_bit_cast(bf16x8, wv); }
            __builtin_amdgcn_s_setprio(1);
#pragma unroll
            for (int dt = 0; dt < 4; ++dt) { o[dt][0] = MFMA16(vf[k2][dt], pb[0], o[dt][0]); o[dt][1] = MFMA16(vf[k2][dt], pb[1], o[dt][1]); }
            lacc[0] = MFMA16(ones, pb[0], lacc[0]); lacc[1] = MFMA16(ones, pb[1], lacc[1]); __builtin_amdgcn_s_setprio(0);
        }
    }
}
DEV void fox_qblock(const Ctx& c, int layer, int b, int h, int qb) {
    const lptr L = c.L; const int tid = c.tid, lane = c.lane, w = c.wave, r16 = lane & 15, g4 = lane >> 4;
    const bf16_t* proj = c.bfp(WS_PROJ); bf16_t* ybuf = c.bfp(WS_Y); float* rss = c.rs(RS_FOX + layer);
    const LAS float* nb = (const LAS float*)(L + O_NB);
    const int q0 = qb * 256 + w * 32;
    const size_t rowb = (size_t)b * SEQ;
    bf16x8 qf[2][2];
#pragma unroll
    for (int qt = 0; qt < 2; ++qt)
#pragma unroll
        for (int ks = 0; ks < 2; ++ks) { const u32x4 raw = *(const u32x4*)(proj + (rowb + q0 + 16 * qt + r16) * NPROJ + C_Q + h * 64 + 32 * ks + 8 * g4);
            float qv[8]; unpack8(raw, qv); constexpr float C1 = 0.125f * 1.4426950408889634f;
            const u32x4 qs = (u32x4){pk2(qv[0] * C1, qv[1] * C1), pk2(qv[2] * C1, qv[3] * C1), pk2(qv[4] * C1, qv[5] * C1), pk2(qv[6] * C1, qv[7] * C1)}; qf[qt][ks] = __builtin_bit_cast(bf16x8, qs); }
    f32x4 o[4][2];
#pragma unroll
    for (int dt = 0; dt < 4; ++dt) { o[dt][0] = (f32x4){0.f, 0.f, 0.f, 0.f}; o[dt][1] = o[dt][0]; }
    float mrun[2] = {-INFINITY, -INFINITY}; f32x4 lacc[2] = {(f32x4){0.f, 0.f, 0.f, 0.f}, (f32x4){0.f, 0.f, 0.f, 0.f}};
    const int NTS = 2 * (qb + 1);
    const int srow = tid >> 3, sch = tid & 7;
    const bf16_t* ksrc = proj + (rowb + srow) * NPROJ + C_K + h * 64 + sch * 8;
    const bf16_t* vsrc = proj + (rowb + srow) * NPROJ + C_V + h * 64 + sch * 8;
    const lptr st0 = L + O_KV + srow * KP + sch * 16, st1 = st0 + 4 * KVB;
#define FOX_LOAD(KA, VA, KB2, VB2, ts_) do { const int tn_ = ((ts_) < NTS) ? (ts_) : NTS - 1; \
        KA = *(const u32x4*)(ksrc + (size_t)tn_ * 128 * NPROJ); VA = *(const u32x4*)(vsrc + (size_t)tn_ * 128 * NPROJ); \
        KB2 = *(const u32x4*)(ksrc + ((size_t)tn_ * 128 + 64) * NPROJ); VB2 = *(const u32x4*)(vsrc + ((size_t)tn_ * 128 + 64) * NPROJ); } while (0)
#define FOX_STORE(st_, KA, VA, KB2, VB2) do { *(LAS u32x4*)(st_) = KA; *(LAS u32x4*)((st_) + KVB) = VA; *(LAS u32x4*)((st_) + 2 * KVB) = KB2; *(LAS u32x4*)((st_) + 3 * KVB) = VB2; } while (0)
    u32x4 kA0, vA0, kA1, vA1, kB0, vB0, kB1, vB1;
    FOX_LOAD(kB0, vB0, kB1, vB1, 0);
    FOX_LOAD(kA0, vA0, kA1, vA1, 1);
    FOX_STORE(st0, kB0, vB0, kB1, vB1);
    WGBAR();
    for (int ts = 0; ts < NTS; ts += 2) {
        FOX_LOAD(kB0, vB0, kB1, vB1, ts + 2);
        __builtin_amdgcn_sched_barrier(0);
        fox_tile(L + O_KV, L + O_KV + KVB, nb, qf, o, mrun, lacc, ts * 128, q0, r16, g4);
        fox_tile(L + O_KV + 2 * KVB, L + O_KV + 3 * KVB, nb, qf, o, mrun, lacc, ts * 128 + 64, q0, r16, g4);
        FOX_STORE(st1, kA0, vA0, kA1, vA1);
        WGBAR();
        FOX_LOAD(kA0, vA0, kA1, vA1, ts + 3);
        __builtin_amdgcn_sched_barrier(0);
        fox_tile(L + O_KV + 4 * KVB, L + O_KV + 5 * KVB, nb, qf, o, mrun, lacc, (ts + 1) * 128, q0, r16, g4);
        fox_tile(L + O_KV + 6 * KVB, L + O_KV + 7 * KVB, nb, qf, o, mrun, lacc, (ts + 1) * 128 + 64, q0, r16, g4);
        FOX_STORE(st0, kB0, vB0, kB1, vB1);
        WGBAR();
    }
#undef FOX_LOAD
#undef FOX_STORE
#pragma unroll
    for (int qt = 0; qt < 2; ++qt) { const float rl = 1.f / lacc[qt][0];
        const size_t row = rowb + q0 + 16 * qt + r16; float ss = 0.f;
#pragma unroll
        for (int dt = 0; dt < 4; ++dt) { const f32x4 v = o[dt][qt] * rl; u32x2 wv; wv.x = cvt_pk_bf16(v[0], v[1]); wv.y = cvt_pk_bf16(v[2], v[3]);
            *(u32x2*)(ybuf + row * DM + 640 + h * 64 + 16 * dt + 4 * g4) = wv; ss += (v[0] * v[0] + v[1] * v[1]) + (v[2] * v[2] + v[3] * v[3]); }
        ss += __shfl_xor(ss, 16); ss += __shfl_xor(ss, 32);
        if (g4 == 0) unsafeAtomicAdd(rss + row, ss); }
}
DEV void fox_unit(const Ctx& c, int layer, int b, int h, int pair) {
    const lptr L = c.L; const int tid = c.tid, lane = c.lane, w = c.wave;
    const float* side = (const float*)(c.ws + WS_SIDE); const float bf = c.in[18][layer * 6 + h];
    LAS float* nb = (LAS float*)(L + O_NB); LAS float* red = (LAS float*)(L + O_RED);
    { float v[4]; float run = 0.f;
#pragma unroll
      for (int i = 0; i < 4; ++i) { const float x = side[((size_t)b * SEQ + 4 * tid + i) * 16 + 6 + h] + bf; run += -softplusf_(-x); v[i] = run; }
      float s = run;
#pragma unroll
      for (int o = 1; o < 64; o <<= 1) { const float t = __shfl_up(s, o); if (lane >= o) s += t; }
      if (lane == 63) red[w] = s;
      WGBAR();
      float base = s - run;
#pragma unroll
      for (int q = 0; q < 8; ++q) if (q < w) base += red[q];
#pragma unroll
      for (int i = 0; i < 4; ++i) nb[4 * tid + i] = -1.4426950408889634f * (base + v[i]);
      WGBAR(); }
    fox_qblock(c, layer, b, h, 7 - pair);
    fox_qblock(c, layer, b, h, pair);
    WGBAR();
}

#ifndef MXMASK
#define MXMASK 7
#endif
DEV Ctx relaunder(const Ctx& c0) { Ctx c = c0; { const __attribute__((address_space(4))) char* k = (const __attribute__((address_space(4))) char*)__builtin_amdgcn_kernarg_segment_ptr(); asm volatile("" : "+s"(k)); c.in.kp = k; }
    { unsigned l = (unsigned)(unsigned long long)c0.L; asm volatile("" : "+s"(l)); c.L = (lptr)l; }
    int t = threadIdx.x; asm volatile("" : "+v"(t)); c.tid = t; c.lane = t & 63; c.wave = __builtin_amdgcn_readfirstlane(t >> 6);
    unsigned long long w = (unsigned long long)c0.ws; asm volatile("" : "+s"(w)); c.ws = (unsigned char*)(__attribute__((address_space(1))) unsigned char*)w;
    unsigned long long o = (unsigned long long)c0.out; asm volatile("" : "+s"(o)); c.out = (float*)(__attribute__((address_space(1))) float*)o; return c; }
struct OneUnit { int pm, pn;
    DEV bool next(int i, Unit& u) const { if (i) return false; u.pm = pm; u.pn = pn; return true; }
    DEV void a_ready(const Unit&) const {}
    DEV void done(const Unit&) const {} };
#ifndef SPINUNIT
#define SPINUNIT 0
#endif
DEV void mixer_phase(const Ctx& c0, int layer) {
    constexpr int N_SSD = NB * 6, N_LRU = NB * 4, N_FOX = NB * 6 * 4, N_ALL = N_SSD + N_LRU + N_FOX;
    constexpr int N_WT1 = (P0_I_L + 7) / 8, N_P1 = (MTOK * PLE / 8) / 4096;
    const int N_END = N_ALL + 1024 + (layer == 0 ? N_WT1 + N_P1 : 0);
    unsigned* ctr = (unsigned*)(c0.ws + WS_CTL) + 64 * layer;
    LAS int* slot = (LAS int*)(c0.L + LDS_BYTES - 16);
    unsigned pend = 0u;
    if (c0.tid == 0) pend = atomicAdd(ctr, 1u);
    for (;;) {
        const Ctx c = relaunder(c0);
        WGBAR();
        if (c.tid == 0) *slot = (int)pend;
        WGBAR();
        const int u = __builtin_amdgcn_readfirstlane(*slot);
        if (c.tid == 0 && u < N_END) pend = atomicAdd(ctr, 1u);
        if (u >= N_END) break;
        if (u >= N_ALL + 1024) {
            const int v = u - (N_ALL + 1024);
            if (v < N_WT1) { const int r = v * 8 + c.wave; if (r < P0_I_L) p0_weight_item(c, 1, r); }
            else p0_p_items(c, 1, (v - N_WT1) * 4096);
            continue; }
        if (u >= N_ALL) {
            const int v = u - N_ALL; int kpp = PLE; asm volatile("" : "+s"(kpp));
            pg8::Gemm g{c.bfp(WS_PB) + (size_t)layer * MTOK * PLE, c.bfp(WS_WPP) + (size_t)layer * 1024 * PLE, MTOK, 1024, kpp}; OneUnit S{v >> 2, v & 3};
            EpiPP E{c.bfp(WS_PP)};
            pg8::gemm_phase<EpiPP, OneUnit, false, true>((PG8_LAS unsigned char*)c.L, g, S, E);
            continue; }
#if SPINUNIT
        const unsigned long long tu0 = __builtin_amdgcn_s_memrealtime();
#endif
        if (u < N_SSD) { if (MXMASK & 1) ssd_unit(c, layer, u / 6, u % 6); }
        else if (u < N_SSD + N_LRU) { const int v = u - N_SSD; if (MXMASK & 2) lru_unit(c, layer, v >> 2, v & 3); }
        else { const int v = u - N_SSD - N_LRU; if (MXMASK & 4) fox_unit(c, layer, v / 24, (v % 24) >> 2, v & 3); }
#if SPINUNIT
        { const int ty = (u < N_SSD) ? 1 : (u < N_SSD + N_LRU ? 2 : 4); if ((SPINUNIT & ty) && c.tid == 0) atomicAdd((unsigned*)(c0.ws + WS_CTL) + 128, (unsigned)(__builtin_amdgcn_s_memrealtime() - tu0)); }
#endif
    }
}
DEV void ynorm_phase(const Ctx& c, int layer) {
    u32x4* y = (u32x4*)c.bfp(WS_Y); const float* r0 = c.rs(RS_SSD + layer); const float* r1 = c.rs(RS_LRU + layer); const float* r2 = c.rs(RS_FOX + layer);
    const int gt = c.bid * 512 + c.tid, NGT = c.G * 512;
    for (int i0 = gt; i0 < MTOK * 128; i0 += 8 * NGT) { u32x4 yv[8]; float ss[8];
#pragma unroll
        for (int q = 0; q < 8; ++q) { const int i = i0 + q * NGT, row = i >> 7, c8 = i & 127; yv[q] = y[i];
            const float* rp = (c8 < 48) ? r0 : (c8 < 80 ? r1 : r2); ss[q] = rp[row] * ((c8 >= 48 && c8 < 80) ? (1.f / 256.f) : (1.f / 384.f)); }
#pragma unroll
        for (int q = 0; q < 8; ++q) { const float sc = rsqrtf(ss[q] + EPSN); float v[8]; unpack8(yv[q], v);
            u32x4 o; o.x = pk2(v[0] * sc, v[1] * sc); o.y = pk2(v[2] * sc, v[3] * sc); o.z = pk2(v[4] * sc, v[5] * sc); o.w = pk2(v[6] * sc, v[7] * sc); y[i0 + q * NGT] = o; } }
}
DEV void final_phase(const Ctx& c) {
    f32x4* o = (f32x4*)c.out; const u32x4* h = (const u32x4*)c.bfp(WS_HBA); const float* rs = c.rs(RS_FINAL); const f32x4* g = (const f32x4*)c.in[29];
    const int gt = c.bid * 512 + c.tid, NGT = c.G * 512;
    for (int i0 = gt; i0 < MTOK * 128; i0 += 8 * NGT) { u32x4 hv[8]; float ss[8];
#pragma unroll
        for (int q = 0; q < 8; ++q) { const int i = i0 + q * NGT; hv[q] = h[i]; ss[q] = rs[i >> 7]; }
#pragma unroll
        for (int q = 0; q < 8; ++q) { const int i = i0 + q * NGT, c8 = i & 127; const float sc = rsqrtf(ss[q] * (1.f / 1024.f) + EPSN);
            float v[8]; unpack8(hv[q], v); const f32x4 g0 = g[2 * c8], g1 = g[2 * c8 + 1];
            __builtin_nontemporal_store((f32x4){v[0] * sc * g0[0], v[1] * sc * g0[1], v[2] * sc * g0[2], v[3] * sc * g0[3]}, o + 2 * (size_t)i); __builtin_nontemporal_store((f32x4){v[4] * sc * g1[0], v[5] * sc * g1[1], v[6] * sc * g1[2], v[7] * sc * g1[3]}, o + 2 * (size_t)i + 1); } }
}

#define XB_TMO      128
#define XB_XCNT(j)  (256  + 64 * (j))
#define XB_XSUB(j)  (1280 + 64 * (j))
#define XB_XGEN(j)  (2304 + 64 * (j))
#define XB_TOP      3328
#define XB_TOPGEN   3392
#define XCD_BAR_WORDS 3456
#define XB_SPIN_CAP (1u << 18)

__device__ __forceinline__ unsigned xb_ld(unsigned* p)              { return __hip_atomic_load(p, __ATOMIC_RELAXED, __HIP_MEMORY_SCOPE_AGENT); }
__device__ __forceinline__ unsigned xb_add(unsigned* p, unsigned v) { return __hip_atomic_fetch_add(p, v, __ATOMIC_RELAXED, __HIP_MEMORY_SCOPE_AGENT); }
__device__ __forceinline__ unsigned xb_xcc_id() { return (unsigned)__builtin_amdgcn_s_getreg((3 << 11) | 20) & 0xFu; }
#define XB_SPIN(cond, bar) do { unsigned _sp = 0; while (cond) { __builtin_amdgcn_s_sleep(1); \
    if ((++_sp & 255u) == 0u) { if (xb_ld(&(bar)[XB_TMO])) break; if (_sp > XB_SPIN_CAP) { atomicAdd(&(bar)[XB_TMO], 1u); break; } } } } while (0)

struct XcdBarrier {
    unsigned* bar; unsigned x;
    volatile LAS unsigned* st;
};

__device__ __forceinline__ XcdBarrier xcd_barrier_post(unsigned* bar, volatile LAS unsigned* st) {
    XcdBarrier b; b.bar = bar; b.x = xb_xcc_id(); b.st = st;
    if (threadIdx.x == 0) (void)xb_add(&bar[XB_XCNT(b.x)], 1u);
    return b;
}
__device__ __forceinline__ void xcd_barrier_complete(unsigned* bar, unsigned x, unsigned& nloc, unsigned& nx) {
    const unsigned G = gridDim.x * gridDim.y * gridDim.z;
    unsigned sum, cnt, mine, sp = 0u;
    for (;;) {
        sum = 0u; cnt = 0u; mine = 0u;
#pragma unroll
        for (unsigned j = 0; j < 16; ++j) { const unsigned c = xb_ld(&bar[XB_XCNT(j)]); sum += c; cnt += (c > 0u) ? 1u : 0u; mine = (j == x) ? c : mine; }
        if (sum == G) break;
        __builtin_amdgcn_s_sleep(1);
        if ((++sp & 255u) == 0u) { if (xb_ld(&bar[XB_TMO])) break; if (sp > XB_SPIN_CAP) { atomicAdd(&bar[XB_TMO], 1u); break; } }
    }
    nloc = mine > 0u ? mine : 1u; nx = cnt > 0u ? cnt : 1u;
}

__device__ __forceinline__ void xcd_barrier(const XcdBarrier& b) {
    asm volatile("s_waitcnt vmcnt(0)" ::: "memory");
    __syncthreads();
    if (threadIdx.x == 0) {
        unsigned* bar = b.bar;
        __builtin_amdgcn_s_waitcnt(0);
        unsigned nloc = b.st[0], nx = b.st[1];
        if (nloc == 0u) { xcd_barrier_complete(bar, b.x, nloc, nx); b.st[0] = nloc; b.st[1] = nx; }
        const unsigned old = xb_add(&bar[XB_XSUB(b.x)], 1u);
        const unsigned gen = old / nloc;
        if (old + 1u == (gen + 1u) * nloc) {
            __builtin_amdgcn_fence(__ATOMIC_RELEASE, "agent");
            asm volatile("s_waitcnt vmcnt(0)" ::: "memory");
            const unsigned og = xb_add(&bar[XB_TOP], 1u);
            const unsigned tg = og / nx;
            if (og + 1u == (tg + 1u) * nx) xb_add(&bar[XB_TOPGEN], 1u);
            else XB_SPIN(xb_ld(&bar[XB_TOPGEN]) == tg, bar);
            __builtin_amdgcn_fence(__ATOMIC_ACQUIRE, "agent");
            xb_add(&bar[XB_XGEN(b.x)], 1u);
            asm volatile("s_waitcnt vmcnt(0)" ::: "memory");
        } else {
            XB_SPIN(xb_ld(&bar[XB_XGEN(b.x)]) == gen, bar);
            __builtin_amdgcn_fence(__ATOMIC_ACQUIRE, "agent");
            asm volatile("s_waitcnt vmcnt(0)" ::: "memory");
        }
    }
    __syncthreads();
}

constexpr int N_PHASES = 16;
#ifndef SPINMASK
#define SPINMASK 0
#endif
#ifndef SPINSYNC
#define SPINSYNC 0
#endif
#ifndef PHMASK
#define PHMASK 511
#endif
__global__ void __launch_bounds__(512, 2) trunk_fwd(Args args) {
    extern __shared__ __attribute__((aligned(16))) unsigned char lds[];
    cg::grid_group grid = cg::this_grid();
    Ctx c;
    c.in.kp = (const __attribute__((address_space(4))) char*)__builtin_amdgcn_kernarg_segment_ptr(); c.out = args.out; c.ws = args.ws; c.L = (lptr)lds; c.tid = threadIdx.x; c.lane = c.tid & 63; c.wave = __builtin_amdgcn_readfirstlane(c.tid >> 6); c.G = gridDim.x; c.bid = blockIdx.x;
    const Ctx cbase = c;
    volatile LAS unsigned* xb_st = (volatile LAS unsigned*)((lptr)lds + LDS_BYTES - 32);
    if (threadIdx.x == 0) { xb_st[0] = 0u; xb_st[1] = 0u; }
    __syncthreads();
    const XcdBarrier xbar = xcd_barrier_post((unsigned*)(args.ws + WS_CTL) + 8192, xb_st);
#if SPINMASK
    unsigned long long spin_acc = 0ull;
#endif
    for (int ph = args.ph_lo; ph < args.ph_hi; ++ph) {
        c = relaunder(cbase);
#if SPINMASK
        const unsigned long long t_ph0 = __builtin_amdgcn_s_memrealtime();
#endif
        if (ph == 0) { if (PHMASK & 1) p0_prologue(c); }
        else if (ph == N_PHASES - 1) { if (PHMASK & 2) final_phase(c); }
        else {
            const int l = (ph - 1) / 7, sp = (ph - 1) % 7;
            bf16_t* const hcur = (l == 0) ? c.bfp(WS_HBA) : (bf16_t*)c.out;
            bf16_t* const hnxt = (l == 0) ? (bf16_t*)c.out : c.bfp(WS_HBA);
            if (sp == 0) { if (PHMASK & 4) {
                pg8::Gemm g{hcur, c.bfp(WS_WIN) + (size_t)l * NPROJ * 1024, MTOK, NPROJ, 1024}; pg8::StaticOrder S; S.init(MTOK, NPROJ, c.G, c.bid);
                EpiProj E{c.bfp(WS_PROJ), c.rs(l == 0 ? RS_IN0 : RS_IN1), (float*)(c.ws + WS_SIDE)};
                pg8::gemm_phase<EpiProj, pg8::StaticOrder, true, true>((PG8_LAS unsigned char*)lds, g, S, E); }
            } else if (sp == 1) { if (PHMASK & 8) mixer_phase(c, l);
            }

            else if (sp == 2) {
                if (PHMASK & 16) ynorm_phase(c, l);
            } else if (sp == 3) { if (PHMASK & 32) {
                pg8::Gemm g{c.bfp(WS_Y), c.bfp(WS_WOUT) + (size_t)l * 1024 * 1024, MTOK, 1024, 1024}; pg8::StaticOrder S; S.init(MTOK, 1024, c.G, c.bid);
                EpiResid E{hcur, hcur, c.rs(RS_N2 + l)};
                pg8::gemm_phase<EpiResid, pg8::StaticOrder, true, true>((PG8_LAS unsigned char*)lds, g, S, E); }
            } else if (sp == 4) { if (PHMASK & 64) {
                pg8::Gemm g{hcur, c.bfp(WS_WGU) + (size_t)l * 5632 * 1024, MTOK, 5632, 1024}; pg8::StaticOrder S; S.init(MTOK, 5632, c.G, c.bid);
                EpiSwiGLU E{c.bfp(WS_PROJ), c.rs(RS_N2 + l)};
                pg8::gemm_phase<EpiSwiGLU, pg8::StaticOrder, true, true>((PG8_LAS unsigned char*)lds, g, S, E); }
            } else if (sp == 5) { if (PHMASK & 128) {
                pg8::Gemm g{c.bfp(WS_PROJ), c.bfp(WS_WDN) + (size_t)l * 1024 * DFF, MTOK, 1024, DFF}; pg8::StaticOrder S; S.init(MTOK, 1024, c.G, c.bid);
                EpiResid E{hcur, hcur, c.rs(RS_N3 + l)};
                pg8::gemm_phase<EpiResid, pg8::StaticOrder, true, true>((PG8_LAS unsigned char*)lds, g, S, E); }
            } else { if (PHMASK & 256) {
                pg8::Gemm g{hcur, c.bfp(WS_WPG) + (size_t)l * 1024 * 1024, MTOK, 1024, 1024}; pg8::StaticOrder S; S.init(MTOK, 1024, c.G, c.bid);
                EpiPle E{hcur, hnxt, c.bfp(WS_PP), c.in[27] + l * 1024, c.rs(RS_N3 + l), c.rs(l == 0 ? RS_IN1 : RS_FINAL)};
                pg8::gemm_phase<EpiPle, pg8::StaticOrder, true, true>((PG8_LAS unsigned char*)lds, g, S, E); }
            }
        }
#if SPINMASK
        const unsigned long long t_ph1 = __builtin_amdgcn_s_memrealtime();
#endif
        if (ph + 1 < args.ph_hi) { if (args.ph_hi < 0) grid.sync(); else xcd_barrier(xbar); }
#if SPINMASK
        { const unsigned long long t_ph2 = __builtin_amdgcn_s_memrealtime(); if ((SPINMASK >> ph) & 1) spin_acc += (SPINSYNC ? (t_ph2 - t_ph1) : (t_ph2 - t_ph0)); }
#endif
    }
#if SPINUNIT
    { const unsigned tot = __hip_atomic_load((unsigned*)(cbase.ws + WS_CTL) + 128, __ATOMIC_RELAXED, __HIP_MEMORY_SCOPE_AGENT); const unsigned long long t_e = __builtin_amdgcn_s_memrealtime(); while (__builtin_amdgcn_s_memrealtime() - t_e < tot / gridDim.x) __builtin_amdgcn_s_sleep(8); }
#endif
#if SPINMASK
    { const unsigned long long t_e = __builtin_amdgcn_s_memrealtime(); while (__builtin_amdgcn_s_memrealtime() - t_e < spin_acc) __builtin_amdgcn_s_sleep(8); }
#endif
}

#ifndef ONE_LAUNCH
#define ONE_LAUNCH 1
#endif
extern "C" void kernel_launch(void* const* d_in, const int* in_sizes, int n_in, void* d_out, int out_size, void* d_ws, size_t ws_size, hipStream_t stream) {
    static int grid = 0;
    if (grid == 0) {
        if (n_in != 30 || out_size != MTOK * DM || ws_size < WS_END) { fprintf(stderr, "kernel_launch: unexpected shapes (n_in %d out %d ws %zu)\n", n_in, out_size, ws_size); grid = -1; return; }
        int dev = 0, cus = 0, per_cu = 0;
        hipGetDevice(&dev); hipDeviceGetAttribute(&cus, hipDeviceAttributeMultiprocessorCount, dev);
        if (hipFuncSetAttribute((const void*)trunk_fwd, hipFuncAttributeMaxDynamicSharedMemorySize, LDS_BYTES) != hipSuccess) { fprintf(stderr, "kernel_launch: hipFuncSetAttribute failed\n"); grid = -1; return; }
        if (hipOccupancyMaxActiveBlocksPerMultiprocessor(&per_cu, (const void*)trunk_fwd, 512, LDS_BYTES) != hipSuccess || per_cu < 1) per_cu = 1;
        (void)hipGetLastError();
        grid = cus * (per_cu > 1 ? 1 : per_cu);
    }
    if (grid < 0) return;
    if (hipMemsetAsync((char*)d_ws + WS_CTL + 32768, 0, 16384, stream) != hipSuccess) { fprintf(stderr, "kernel_launch: hipMemsetAsync failed\n"); return; }
    Args a{};
    for (int i = 0; i < 30; ++i) a.in[i] = (const float*)d_in[i];
    a.out = (float*)d_out; a.ws = (unsigned char*)d_ws;
#if ONE_LAUNCH
    a.ph_lo = 0; a.ph_hi = N_PHASES;
    void* kargs[] = {&a};
    hipError_t e = hipLaunchCooperativeKernel((const void*)trunk_fwd, dim3(grid), dim3(512), kargs, LDS_BYTES, stream);
    if (e != hipSuccess) fprintf(stderr, "cooperative launch failed: %s (grid %d)\n", hipGetErrorString(e), grid);
#else
    for (int ph = 0; ph < N_PHASES; ++ph) { a.ph_lo = ph; a.ph_hi = ph + 1; hipLaunchKernelGGL(trunk_fwd, dim3(grid), dim3(512), LDS_BYTES, stream, a); }
#endif
}
```
